# Optimizing an MI355X kernel written in HIP

```python
import math, functools
import jax, jax.numpy as jnp
from jax import lax
import numpy as np

D_MODEL = 2048
BATCH = 8
SEQ = 2048
DEPTH = 4

GRID_W = 64
CTX_LEN = 256
Q_BLOCK = 128
ROPE_BASE = 10000.0
NORM_EPS = 1e-6
N_MIXERS = 3

DA_HEAD_DIM = 64
DA_HEADS = D_MODEL // (2 * DA_HEAD_DIM)
DA_V_DIM = 2 * DA_HEAD_DIM

GQ_HEAD_DIM = 128
GQ_HEADS = D_MODEL // GQ_HEAD_DIM
GQ_KV_HEADS = GQ_HEADS // 4
GQ_Q_W = GQ_HEADS * GQ_HEAD_DIM
GQ_KV_W = GQ_KV_HEADS * GQ_HEAD_DIM

ML_NOPE_DIM = 128
ML_ROPE_DIM = 64
ML_V_DIM = 128
ML_HEADS = D_MODEL // ML_V_DIM
ML_Q_RANK = D_MODEL // 4
ML_KV_RANK = D_MODEL // 4

kernel_name = 'hybrid_diffattn_gqa_mla_prefix_dit'


def rmsnorm(x, g):
    xf = x.astype(jnp.float32)
    y = xf * lax.rsqrt(jnp.mean(xf * xf, axis=-1, keepdims=True) + NORM_EPS)
    return (y * g.astype(jnp.float32)).astype(x.dtype)


def rope_1d(x, pos):
    half = x.shape[-1] // 2
    inv_freq = ROPE_BASE ** (-jnp.arange(half, dtype=jnp.float32) / half)
    ang = pos[:, None] * inv_freq[None, :]
    cos = jnp.cos(ang)[None, :, None, :]
    sin = jnp.sin(ang)[None, :, None, :]
    xf = x.astype(jnp.float32)
    x1, x2 = xf[..., :half], xf[..., half:]
    return jnp.concatenate([x1 * cos - x2 * sin, x1 * sin + x2 * cos], axis=-1).astype(x.dtype)


def rope_2d(x, rows, cols):
    d = x.shape[-1] // 2
    return jnp.concatenate([rope_1d(x[..., :d], rows), rope_1d(x[..., d:], cols)], axis=-1)


def grid_positions(n_tokens):
    n_rows = n_tokens // GRID_W
    rows = jnp.repeat(jnp.arange(n_rows, dtype=jnp.float32), GRID_W)
    cols = jnp.tile(jnp.arange(GRID_W, dtype=jnp.float32), n_rows)
    return rows, cols


def sweep_query_blocks(fn, qs):
    b, s = qs[0].shape[:2]
    nb = s // Q_BLOCK
    blocks = tuple(jnp.swapaxes(q.reshape((b, nb, Q_BLOCK) + q.shape[2:]), 0, 1) for q in qs)
    out = lax.map(lambda blk: fn(*blk), blocks)
    out = jnp.swapaxes(out, 0, 1)
    return out.reshape((b, s) + out.shape[3:])


def lambda_init_fn(layer):
    return 0.8 - 0.6 * math.exp(-0.3 * layer)


def diff_attn_core(q, k, v, lam):
    s = jnp.einsum('bqhnd,bkhnd->bhnqk', q, k).astype(jnp.float32) * (DA_HEAD_DIM ** -0.5)
    p = jax.nn.softmax(s, axis=-1)
    a = p[:, :, 0] - lam * p[:, :, 1]
    return jnp.einsum('bhqk,bkhe->bqhe', a.astype(v.dtype), v)


def diff_attn_mixer(xl, xc, need_ctx, *, rows, cols, w_in, lam_q1, lam_k1, lam_q2, lam_k2, subln_g, w_out, lambda_init):
    f32 = jnp.float32
    lam = (jnp.exp(jnp.sum(lam_q1.astype(f32) * lam_k1.astype(f32)))
           - jnp.exp(jnp.sum(lam_q2.astype(f32) * lam_k2.astype(f32))) + lambda_init)

    def project(x, use_rope):
        b, s, _ = x.shape
        q, k, v, g = jnp.split(x @ w_in, 4, axis=-1)
        q = q.reshape(b, s, 2 * DA_HEADS, DA_HEAD_DIM)
        k = k.reshape(b, s, 2 * DA_HEADS, DA_HEAD_DIM)
        if use_rope:
            q = rope_2d(q, rows, cols)
            k = rope_2d(k, rows, cols)
        q = q.reshape(b, s, DA_HEADS, 2, DA_HEAD_DIM)
        k = k.reshape(b, s, DA_HEADS, 2, DA_HEAD_DIM)
        v = v.reshape(b, s, DA_HEADS, DA_V_DIM)
        return q, k, v, g

    def finish(o, g):
        o = rmsnorm(o, subln_g) * (1.0 - lambda_init)
        o = o.reshape(o.shape[:2] + (D_MODEL,)) * jax.nn.silu(g)
        return o @ w_out

    ql, kl, vl, gl = project(xl, True)
    qc, kc, vc, gc = project(xc, False)
    k_all = jnp.concatenate([kl, kc], axis=1)
    v_all = jnp.concatenate([vl, vc], axis=1)
    ol = sweep_query_blocks(lambda q: diff_attn_core(q, k_all, v_all, lam), (ql,))
    yl = finish(ol, gl)
    yc = finish(diff_attn_core(qc, kc, vc, lam), gc) if need_ctx else None
    return yl, yc


def gqa_core(q, k, v):
    s = jnp.einsum('bqgrd,bkgd->bgrqk', q, k).astype(jnp.float32) * (GQ_HEAD_DIM ** -0.5)
    p = jax.nn.softmax(s, axis=-1)
    return jnp.einsum('bgrqk,bkgd->bqgrd', p.astype(v.dtype), v)


def gqa_mixer(xl, xc, need_ctx, *, rows, cols, w_in, q_norm_g, k_norm_g, w_out):
    rep = GQ_HEADS // GQ_KV_HEADS

    def project(x, use_rope):
        b, s, _ = x.shape
        q, k, v, g = jnp.split(x @ w_in, [GQ_Q_W, GQ_Q_W + GQ_KV_W, GQ_Q_W + 2 * GQ_KV_W], axis=-1)
        q = rmsnorm(q.reshape(b, s, GQ_HEADS, GQ_HEAD_DIM), q_norm_g)
        k = rmsnorm(k.reshape(b, s, GQ_KV_HEADS, GQ_HEAD_DIM), k_norm_g)
        v = v.reshape(b, s, GQ_KV_HEADS, GQ_HEAD_DIM)
        if use_rope:
            q = rope_2d(q, rows, cols)
            k = rope_2d(k, rows, cols)
        q = q.reshape(b, s, GQ_KV_HEADS, rep, GQ_HEAD_DIM)
        return q, k, v, g

    def finish(o, g):
        o = o.reshape(o.shape[:2] + (D_MODEL,)) * jax.nn.silu(g)
        return o @ w_out

    ql, kl, vl, gl = project(xl, True)
    qc, kc, vc, gc = project(xc, False)
    k_all = jnp.concatenate([kl, kc], axis=1)
    v_all = jnp.concatenate([vl, vc], axis=1)
    ol = sweep_query_blocks(lambda q: gqa_core(q, k_all, v_all), (ql,))
    yl = finish(ol, gl)
    yc = finish(gqa_core(qc, kc, vc), gc) if need_ctx else None
    return yl, yc


def mla_core(q_n, q_r, k_n, k_r, v):
    s = (jnp.einsum('bqhd,bkhd->bhqk', q_n, k_n).astype(jnp.float32)
         + jnp.einsum('bqhd,bkd->bhqk', q_r, k_r).astype(jnp.float32))
    p = jax.nn.softmax(s * ((ML_NOPE_DIM + ML_ROPE_DIM) ** -0.5), axis=-1)
    return jnp.einsum('bhqk,bkhd->bqhd', p.astype(v.dtype), v)


def mla_mixer(xl, xc, need_ctx, *, rows, cols, w_in, q_a_norm_g, w_q_b, kv_a_norm_g, w_kv_b, w_out):
    def project(x, use_rope):
        b, s, _ = x.shape
        q_a, kv_a, k_r, g = jnp.split(
            x @ w_in, [ML_Q_RANK, ML_Q_RANK + ML_KV_RANK, ML_Q_RANK + ML_KV_RANK + ML_ROPE_DIM], axis=-1)
        q = (rmsnorm(q_a, q_a_norm_g) @ w_q_b).reshape(b, s, ML_HEADS, ML_NOPE_DIM + ML_ROPE_DIM)
        q_n, q_r = q[..., :ML_NOPE_DIM], q[..., ML_NOPE_DIM:]
        kv = (rmsnorm(kv_a, kv_a_norm_g) @ w_kv_b).reshape(b, s, ML_HEADS, ML_NOPE_DIM + ML_V_DIM)
        k_n, v = kv[..., :ML_NOPE_DIM], kv[..., ML_NOPE_DIM:]
        k_r = k_r[:, :, None, :]
        if use_rope:
            q_r = rope_2d(q_r, rows, cols)
            k_r = rope_2d(k_r, rows, cols)
        return q_n, q_r, k_n, k_r[:, :, 0, :], v, g

    def finish(o, g):
        o = o.reshape(o.shape[:2] + (ML_HEADS * ML_V_DIM,)) * jax.nn.silu(g)
        return o @ w_out

    qnl, qrl, knl, krl, vl, gl = project(xl, True)
    qnc, qrc, knc, krc, vc, gc = project(xc, False)
    kn_all = jnp.concatenate([knl, knc], axis=1)
    kr_all = jnp.concatenate([krl, krc], axis=1)
    v_all = jnp.concatenate([vl, vc], axis=1)
    ol = sweep_query_blocks(lambda qn, qr: mla_core(qn, qr, kn_all, kr_all, v_all), (qnl, qrl))
    yl = finish(ol, gl)
    yc = finish(mla_core(qnc, qrc, knc, krc, vc), gc) if need_ctx else None
    return yl, yc


def sandwich_layer(h_lat, h_ctx, c, c_ctx, ada_w, ada_b, pre_g, post_g, mixer_fn, need_ctx):
    shift, scale, gate = jnp.split(jax.nn.silu(c)[:, None, :] @ ada_w + ada_b, 3, axis=-1)
    shift_c, scale_c, gate_c = jnp.split(jax.nn.silu(c_ctx)[None, None, :] @ ada_w + ada_b, 3, axis=-1)
    xl = rmsnorm(h_lat, pre_g) * (1.0 + scale) + shift
    xc = rmsnorm(h_ctx, pre_g) * (1.0 + scale_c) + shift_c
    yl, yc = mixer_fn(xl, xc, need_ctx)
    h_lat = h_lat + gate * rmsnorm(yl, post_g)
    if need_ctx:
        h_ctx = h_ctx + gate_c * rmsnorm(yc, post_g)
    return h_lat, h_ctx


def setup_inputs(seed: int = 0) -> dict:
    key = jax.random.key(seed)
    keys = iter(jax.random.split(key, 64))
    f32 = jnp.float32

    def dense(fan_in, fan_out, gain=1.0):
        return jax.random.normal(next(keys), (fan_in, fan_out), f32) * (gain * fan_in ** -0.5)

    def norm_gain(n):
        return 1.0 + 0.02 * jax.random.normal(next(keys), (n,), f32)

    def small(n, s):
        return s * jax.random.normal(next(keys), (n,), f32)

    p = {
        'x': jax.random.normal(next(keys), (BATCH, SEQ, D_MODEL), f32),
        'c': jax.random.normal(next(keys), (BATCH, D_MODEL), f32),
        'ctx': jax.random.normal(next(keys), (BATCH, CTX_LEN, D_MODEL), f32),
        'c_ctx': jax.random.normal(next(keys), (D_MODEL,), f32),
    }
    for l in range(DEPTH):
        kind = l % N_MIXERS
        pre = 'l%d_' % l
        p[pre + 'ada_w'] = dense(D_MODEL, 3 * D_MODEL, 0.5)
        p[pre + 'ada_b'] = small(3 * D_MODEL, 0.01)
        p[pre + 'pre_g'] = norm_gain(D_MODEL)
        p[pre + 'post_g'] = norm_gain(D_MODEL)
        if kind == 0:
            p[pre + 'w_in'] = dense(D_MODEL, 4 * D_MODEL)
            for name in ('lam_q1', 'lam_k1', 'lam_q2', 'lam_k2'):
                p[pre + name] = small(DA_HEAD_DIM, 0.1)
            p[pre + 'subln_g'] = norm_gain(DA_V_DIM)
        elif kind == 1:
            p[pre + 'w_in'] = dense(D_MODEL, GQ_Q_W + 2 * GQ_KV_W + D_MODEL)
            p[pre + 'q_norm_g'] = norm_gain(GQ_HEAD_DIM)
            p[pre + 'k_norm_g'] = norm_gain(GQ_HEAD_DIM)
        else:
            p[pre + 'w_in'] = dense(D_MODEL, ML_Q_RANK + ML_KV_RANK + ML_ROPE_DIM + D_MODEL)
            p[pre + 'q_a_norm_g'] = norm_gain(ML_Q_RANK)
            p[pre + 'w_q_b'] = dense(ML_Q_RANK, ML_HEADS * (ML_NOPE_DIM + ML_ROPE_DIM))
            p[pre + 'kv_a_norm_g'] = norm_gain(ML_KV_RANK)
            p[pre + 'w_kv_b'] = dense(ML_KV_RANK, ML_HEADS * (ML_NOPE_DIM + ML_V_DIM))
        p[pre + 'w_out'] = dense(D_MODEL, D_MODEL)
    return p


def reference(x, c, ctx, c_ctx,
              l0_ada_w, l0_ada_b, l0_pre_g, l0_post_g, l0_w_in, l0_lam_q1, l0_lam_k1, l0_lam_q2, l0_lam_k2, l0_subln_g, l0_w_out,
              l1_ada_w, l1_ada_b, l1_pre_g, l1_post_g, l1_w_in, l1_q_norm_g, l1_k_norm_g, l1_w_out,
              l2_ada_w, l2_ada_b, l2_pre_g, l2_post_g, l2_w_in, l2_q_a_norm_g, l2_w_q_b, l2_kv_a_norm_g, l2_w_kv_b, l2_w_out,
              l3_ada_w, l3_ada_b, l3_pre_g, l3_post_g, l3_w_in, l3_lam_q1, l3_lam_k1, l3_lam_q2, l3_lam_k2, l3_subln_g, l3_w_out):
    rows, cols = grid_positions(x.shape[1])
    common = [
        (l0_ada_w, l0_ada_b, l0_pre_g, l0_post_g),
        (l1_ada_w, l1_ada_b, l1_pre_g, l1_post_g),
        (l2_ada_w, l2_ada_b, l2_pre_g, l2_post_g),
        (l3_ada_w, l3_ada_b, l3_pre_g, l3_post_g),
    ]
    mixers = [
        functools.partial(diff_attn_mixer, rows=rows, cols=cols, w_in=l0_w_in, lam_q1=l0_lam_q1, lam_k1=l0_lam_k1,
                          lam_q2=l0_lam_q2, lam_k2=l0_lam_k2, subln_g=l0_subln_g, w_out=l0_w_out,
                          lambda_init=lambda_init_fn(0)),
        functools.partial(gqa_mixer, rows=rows, cols=cols, w_in=l1_w_in, q_norm_g=l1_q_norm_g,
                          k_norm_g=l1_k_norm_g, w_out=l1_w_out),
        functools.partial(mla_mixer, rows=rows, cols=cols, w_in=l2_w_in, q_a_norm_g=l2_q_a_norm_g, w_q_b=l2_w_q_b,
                          kv_a_norm_g=l2_kv_a_norm_g, w_kv_b=l2_w_kv_b, w_out=l2_w_out),
        functools.partial(diff_attn_mixer, rows=rows, cols=cols, w_in=l3_w_in, lam_q1=l3_lam_q1, lam_k1=l3_lam_k1,
                          lam_q2=l3_lam_q2, lam_k2=l3_lam_k2, subln_g=l3_subln_g, w_out=l3_w_out,
                          lambda_init=lambda_init_fn(3)),
    ]
    h, hc = x, ctx
    for l in range(DEPTH):
        h, hc = sandwich_layer(h, hc, c, c_ctx, *common[l], mixers[l], l < DEPTH - 1)
    return h
```

```cpp
#include <hip/hip_runtime.h>
#include <hip/hip_cooperative_groups.h>
#include <cstdio>
#include <cstdint>
namespace cg = cooperative_groups;
#ifndef GOUT_SPLIT
#define GOUT_SPLIT 0
#endif
__device__ __forceinline__ int otid() { int t = threadIdx.x; asm volatile("" : "+v"(t)); return t; }
namespace pg8 {
#define PG8_LAS __attribute__((address_space(3)))
typedef unsigned short bf16_t;
typedef short bf16x8 __attribute__((ext_vector_type(8)));
typedef float f32x4 __attribute__((ext_vector_type(4)));
typedef unsigned u32x4 __attribute__((ext_vector_type(4)));
constexpr int BM = 256, BK = 64, HALF = 128, HTB = HALF * BK * 2  , STAGE_BYTES = 8 * HTB, NXCD = 8, WGM = 8;

__host__ __device__ __forceinline__ int lds_byte(int r, int c) { const int st = (r >> 4) * 2 + (c >> 5), rr = r & 15, cc = c & 31, ob = rr * 64 + cc * 2; return st * 1024 + (ob ^ (((ob >> 9) & 1) << 5)); }
__host__ __device__ __forceinline__ void stage_rc(int b, int& R, int& C) { const int st = b / 1024, sb = b % 1024, swz = sb ^ (((sb >> 9) & 1) << 5); R = (st >> 1) * 16 + swz / 64; C = (st & 1) * 32 + (swz % 64) / 2; }
__host__ __device__ __forceinline__ int perm32(int rho) { const int n = rho >> 4, i = rho & 15; return 8 * (i >> 2) + 4 * n + (i & 3); }

struct Unit { int pm, pn; };
struct Gemm { const bf16_t* A; const bf16_t* Bt; int M, N, K, ld; };

struct StaticOrder {
    int nM, nN, nwg, G, c; bool skip9 = false; bool one = false; int opm = 0, opn = 0;
    __host__ __device__ void init(int M, int N, int G_, int c_) { nM = M / BM; nN = N / BM; nwg = nM * nN; G = G_; c = c_; }
    __host__ __device__ bool next(int i, Unit& u) const {
        if (one) { if (i > 0) return false; u.pm = opm; u.pn = opn; return true; }
        const long L = (long)i * G + c; if (L >= nwg) return false;
        int wgid = (int)L; { const int q = nwg / NXCD, r = nwg % NXCD, xcd = wgid % NXCD, off = wgid / NXCD; wgid = (xcd < r ? xcd * (q + 1) : r * (q + 1) + (xcd - r) * q) + off; }
        const int nig = WGM * nN, gid = wgid / nig, fm = gid * WGM, gsz = (nM - fm) < WGM ? (nM - fm) : WGM;
        u.pm = fm + ((wgid % nig) % gsz); u.pn = (wgid % nig) / gsz; if (skip9) u.pm += u.pm >> 3; return true;
    }
    __device__ __forceinline__ void a_ready(const Unit&) const {}
    __device__ __forceinline__ void done(const Unit&) const {}
};
__device__ __forceinline__ unsigned cvt_pk_bf16(float lo, float hi) { unsigned r; asm volatile("v_cvt_pk_bf16_f32 %0, %1, %2" : "=v"(r) : "v"(lo), "v"(hi)); return r; }
template <class Epi, class Sched, bool ALIGN_EPI = false, bool SP2 = false>
__device__ __forceinline__ void gemm_phase(PG8_LAS unsigned char* lds, const Gemm g, const Sched& S, const Epi& E) {
    const int tid = otid(), wid = __builtin_amdgcn_readfirstlane(tid >> 6), lane = tid & 63, wr = wid >> 2, wc = wid & 3, fr = lane & 15, fq = lane >> 4;
    const int K = g.K, nt = K / BK, LD = g.ld;
    unsigned voffA[2], voffB[2];
#pragma unroll
    for (int i = 0; i < 2; ++i) { int R, C; stage_rc(tid * 16 + i * 8192, R, C); const int Rb = Epi::PERM ? ((R & ~31) + perm32(R & 31)) : R;
        voffA[i] = (unsigned)(R * LD + C) * 2u; voffB[i] = (unsigned)(Rb * LD + C) * 2u; }
    const size_t kstep = (size_t)(BK * 2);
    const size_t hstep = (size_t)HALF * LD * 2;
    const size_t tstep = 2 * hstep;
    const unsigned ldsw = (unsigned)wid * 1024u;
    const int aoff = lds_byte(wr * 64 + fr, fq * 8), boff = lds_byte(wc * 32 + fr, fq * 8);
#define PG8_SA(b, h) (((b) * 2 + (h)) * HTB)
#define PG8_SB(b, h) ((4 + (b) * 2 + (h)) * HTB)
#define PG8_STAGE(bufoff, gbase, voff) do { _Pragma("unroll") for (int _i = 0; _i < 2; ++_i) \
        __builtin_amdgcn_global_load_lds((const unsigned*)((const char*)(gbase) + (voff)[_i]), (PG8_LAS unsigned*)(lds + (bufoff) + ldsw + _i * 8192), 16, 0, 0); } while (0)
#define PG8_LDA(dst, b, h) do { _Pragma("unroll") for (int m = 0; m < 4; ++m) _Pragma("unroll") for (int k = 0; k < 2; ++k) dst[m][k] = *(const PG8_LAS bf16x8*)(lds + PG8_SA(b, h) + aoff + m * 2048 + k * 1024); } while (0)
#define PG8_LDB(dst, b, h) do { _Pragma("unroll") for (int n = 0; n < 2; ++n) _Pragma("unroll") for (int k = 0; k < 2; ++k) dst[n][k] = *(const PG8_LAS bf16x8*)(lds + PG8_SB(b, h) + boff + n * 2048 + k * 1024); } while (0)
#define PG8_MMA(ai, bj, At, Bt) do { __builtin_amdgcn_s_setprio(1); _Pragma("unroll") for (int m = 0; m < 4; ++m) _Pragma("unroll") for (int n = 0; n < 2; ++n) _Pragma("unroll") for (int k = 0; k < 2; ++k) \
        acc[ai][bj][m][n] = __builtin_amdgcn_mfma_f32_16x16x32_bf16(Bt[n][k], At[m][k], acc[ai][bj][m][n], 0, 0, 0); __builtin_amdgcn_s_setprio(0); } while (0)
#define PG8_WAIT_V(n) asm volatile("s_waitcnt vmcnt(" #n ")" ::: "memory")
#define PG8_WAIT_L(n) asm volatile("s_waitcnt lgkmcnt(" #n ")" ::: "memory")
#define PG8_BAR __builtin_amdgcn_s_barrier()
#define PG8_SCHED __builtin_amdgcn_sched_barrier(0)
    Unit cur, nxt; int ui = 0;
    if (!S.next(0, cur)) return;
    f32x4 acc[2][2][4][2];
#pragma unroll
    for (int a = 0; a < 2; ++a)
#pragma unroll
        for (int b = 0; b < 2; ++b)
#pragma unroll
            for (int m = 0; m < 4; ++m)
#pragma unroll
                for (int n = 0; n < 2; ++n) acc[a][b][m][n] = (f32x4){0.f, 0.f, 0.f, 0.f};
    bf16x8 At[4][2], B0[2][2], B1[2][2];
    const char* cA = (const char*)g.A + (size_t)cur.pm * tstep; const char* cB = (const char*)g.Bt + (size_t)cur.pn * tstep;
    S.a_ready(cur);
    if constexpr (SP2) {
        PG8_STAGE(PG8_SB(0, 0), cB, voffB); PG8_STAGE(PG8_SB(0, 1), cB + hstep, voffB); PG8_STAGE(PG8_SA(0, 0), cA, voffA); PG8_STAGE(PG8_SA(0, 1), cA + hstep, voffA);
        if (wr == 1) PG8_BAR;
        PG8_WAIT_V(2); PG8_BAR;
        PG8_STAGE(PG8_SB(1, 0), cB + kstep, voffB); PG8_STAGE(PG8_SA(1, 0), cA + kstep, voffA); PG8_STAGE(PG8_SB(1, 1), cB + hstep + kstep, voffB);
        PG8_WAIT_V(6); PG8_BAR;
    } else {
        PG8_STAGE(PG8_SB(0, 0), cB, voffB); PG8_STAGE(PG8_SA(0, 0), cA, voffA); PG8_STAGE(PG8_SB(0, 1), cB + hstep, voffB); PG8_STAGE(PG8_SA(0, 1), cA + hstep, voffA);
        if (wr == 1) PG8_BAR;
        PG8_WAIT_V(4); PG8_BAR;
        PG8_STAGE(PG8_SB(1, 0), cB + kstep, voffB); PG8_STAGE(PG8_SA(1, 0), cA + kstep, voffA); PG8_STAGE(PG8_SB(1, 1), cB + hstep + kstep, voffB);
        PG8_WAIT_V(6); PG8_BAR;
    }
    for (;;) {
        const bool has_next = S.next(ui + 1, nxt);
        const char* nA = has_next ? (const char*)g.A + (size_t)nxt.pm * tstep : cA; const char* nB = has_next ? (const char*)g.Bt + (size_t)nxt.pn * tstep : cB;
        for (int t = 0; t < nt; t += 2) {
            const bool last = (t == nt - 2);
            const char* a1 = cA + (size_t)(t + 1) * kstep;
            const char* a2 = last ? nA : cA + (size_t)(t + 2) * kstep; const char* b2 = last ? nB : cB + (size_t)(t + 2) * kstep;
            const char* a3 = a2 + kstep; const char* b3 = b2 + kstep;
            if (last && has_next) S.a_ready(nxt);
            if constexpr (SP2) {
            PG8_LDB(B0, 0, 0); PG8_LDB(B1, 0, 1); PG8_SCHED; PG8_LDA(At, 0, 0); PG8_STAGE(PG8_SA(1, 1), a1 + hstep, voffA);
            PG8_WAIT_V(8); PG8_WAIT_L(0); PG8_BAR; PG8_MMA(0, 0, At, B0); PG8_MMA(0, 1, At, B1); PG8_BAR; PG8_SCHED;
            PG8_LDA(At, 0, 1); PG8_STAGE(PG8_SB(0, 0), b2, voffB); PG8_STAGE(PG8_SB(0, 1), b2 + hstep, voffB); PG8_STAGE(PG8_SA(0, 0), a2, voffA);
            PG8_WAIT_V(8); PG8_WAIT_L(0); PG8_BAR; PG8_MMA(1, 0, At, B0); PG8_MMA(1, 1, At, B1); PG8_BAR; PG8_SCHED;
            PG8_LDB(B0, 1, 0); PG8_LDB(B1, 1, 1); PG8_SCHED; PG8_LDA(At, 1, 0); PG8_STAGE(PG8_SA(0, 1), a2 + hstep, voffA);
            PG8_WAIT_V(8); PG8_WAIT_L(0); PG8_BAR; PG8_MMA(0, 0, At, B0); PG8_MMA(0, 1, At, B1); PG8_BAR; PG8_SCHED;
            PG8_LDA(At, 1, 1); PG8_STAGE(PG8_SB(1, 0), b3, voffB); PG8_STAGE(PG8_SB(1, 1), b3 + hstep, voffB); PG8_STAGE(PG8_SA(1, 0), a3, voffA);
            PG8_WAIT_V(8); PG8_WAIT_L(0); PG8_BAR; PG8_MMA(1, 0, At, B0); PG8_MMA(1, 1, At, B1); PG8_BAR; PG8_SCHED;
            } else {
            PG8_LDB(B0, 0, 0); PG8_SCHED; PG8_LDA(At, 0, 0); PG8_STAGE(PG8_SA(1, 1), a1 + hstep, voffA);
            PG8_WAIT_L(8); PG8_BAR; PG8_WAIT_L(0); PG8_MMA(0, 0, At, B0); PG8_BAR; PG8_SCHED;
            PG8_LDB(B1, 0, 1); PG8_STAGE(PG8_SB(0, 0), b2, voffB);
            PG8_BAR; PG8_WAIT_L(0); PG8_MMA(0, 1, At, B1); PG8_BAR;
            PG8_LDA(At, 0, 1); PG8_STAGE(PG8_SA(0, 0), a2, voffA);
            PG8_BAR; PG8_WAIT_L(0); PG8_MMA(1, 0, At, B0); PG8_BAR; PG8_SCHED;
            PG8_STAGE(PG8_SB(0, 1), b2 + hstep, voffB);
            PG8_WAIT_V(6); PG8_BAR; PG8_MMA(1, 1, At, B1); PG8_BAR;
            PG8_LDB(B0, 1, 0); PG8_SCHED; PG8_LDA(At, 1, 0); PG8_STAGE(PG8_SA(0, 1), a2 + hstep, voffA);
            PG8_WAIT_L(8); PG8_BAR; PG8_WAIT_L(0); PG8_MMA(0, 0, At, B0); PG8_BAR; PG8_SCHED;
            PG8_LDB(B1, 1, 1); PG8_STAGE(PG8_SB(1, 0), b3, voffB);
            PG8_BAR; PG8_WAIT_L(0); PG8_MMA(0, 1, At, B1); PG8_BAR;
            PG8_LDA(At, 1, 1); PG8_STAGE(PG8_SA(1, 0), a3, voffA);
            PG8_BAR; PG8_WAIT_L(0); PG8_MMA(1, 0, At, B0); PG8_BAR; PG8_SCHED;
            PG8_STAGE(PG8_SB(1, 1), b3 + hstep, voffB);
            PG8_WAIT_V(6); PG8_BAR; PG8_MMA(1, 1, At, B1); PG8_BAR;
            }
        }
        if constexpr (ALIGN_EPI) { if (wr == 0) PG8_BAR; }
        if constexpr (!Epi::AFTER_DRAIN) { E(acc, cur, wr, wc, fr, fq); S.done(cur); }
        if (!has_next) break;
#pragma unroll
        for (int a = 0; a < 2; ++a)
#pragma unroll
            for (int b = 0; b < 2; ++b)
#pragma unroll
                for (int m = 0; m < 4; ++m)
#pragma unroll
                    for (int n = 0; n < 2; ++n) acc[a][b][m][n] = (f32x4){0.f, 0.f, 0.f, 0.f};
        cur = nxt; cA = nA; cB = nB; ++ui;
        if constexpr (ALIGN_EPI) { if (wr == 1) PG8_BAR; }
    }
    PG8_WAIT_V(0);
    if constexpr (!ALIGN_EPI) { if (wr == 0) PG8_BAR; }
    PG8_BAR;
    if constexpr (Epi::AFTER_DRAIN) { E.fused(acc, cur, wr, wc, fr, fq, lds, wid, lane); S.done(cur); }
#undef PG8_SA
#undef PG8_SB
#undef PG8_STAGE
#undef PG8_LDA
#undef PG8_LDB
#undef PG8_MMA
#undef PG8_WAIT_V
#undef PG8_WAIT_L
#undef PG8_BAR
#undef PG8_SCHED
}
}

constexpr int NB = 8, SEQ = 2048, CTXL = 256, TB = SEQ + CTXL  , MROWS = NB * TB  , DM = 2048;
constexpr float NORM_EPS = 1e-6f;
constexpr int NWAVES = 8;
constexpr int LDS_BYTES = 155648;
constexpr size_t MiB = 1u << 20;
constexpr size_t OFF_ADA = 0;
constexpr size_t OFF_BAR = 960 * 1024;
constexpr size_t OFF_WIN = 1 * MiB;
constexpr size_t OFF_WOUT = OFF_WIN + 32 * MiB;
constexpr size_t OFF_WQB = OFF_WOUT + 8 * MiB;
constexpr size_t OFF_WKVB = OFF_WQB + 3 * MiB;
constexpr size_t OFF_HB = OFF_WKVB + 4 * MiB;
constexpr size_t OFF_KR = OFF_HB + 72 * MiB;
constexpr size_t OFF_XN = OFF_KR + 3 * MiB;
constexpr size_t OFF_Q = OFF_XN + 72 * MiB;
constexpr size_t OFF_K = OFF_Q + 108 * MiB;
constexpr size_t OFF_V = OFF_K + 72 * MiB;
constexpr size_t OFF_G = OFF_V + 72 * MiB;
constexpr size_t WS_END = OFF_G + 72 * MiB;
constexpr int ADA_SPLIT = 16;

#define GAS __attribute__((address_space(1)))
#define LAS __attribute__((address_space(3)))
typedef unsigned short bf16_t;
typedef unsigned v4u __attribute__((ext_vector_type(4)));
typedef unsigned v2u __attribute__((ext_vector_type(2)));
typedef float f32x4 __attribute__((ext_vector_type(4)));
#define LDS_WAIT() asm volatile("s_waitcnt lgkmcnt(0)" ::: "memory")
__device__ __forceinline__ unsigned f2bf(float f) { unsigned u = __builtin_bit_cast(unsigned, f); return (u + 0x7fffu + ((u >> 16) & 1u)) >> 16; }
__device__ __forceinline__ unsigned pk2(float lo, float hi) { return f2bf(lo) | (f2bf(hi) << 16); }
__device__ __forceinline__ float bflo(unsigned w) { return __builtin_bit_cast(float, w << 16); }
__device__ __forceinline__ float bfhi(unsigned w) { return __builtin_bit_cast(float, w & 0xffff0000u); }
__device__ __forceinline__ float bf1(bf16_t h) { return __builtin_bit_cast(float, (unsigned)h << 16); }
__device__ __forceinline__ float wave_sum(float v) {
#pragma unroll
    for (int o = 1; o < 64; o <<= 1) v += __shfl_xor(v, o);
    return v;
}
__device__ __forceinline__ float silu_f(float x) { return x / (1.f + __expf(-x)); }

enum { PH_PRO = 0, PH_ADA,
       PH_L0_ROW, PH_L0_GIN, PH_L0_ATT, PH_L0_GOUT,
       PH_L1_ROW, PH_L1_GIN, PH_L1_POST, PH_L1_ATT, PH_L1_GOUT,
       PH_L2_ROW, PH_L2_GIN, PH_L2_POST, PH_L2_GQ, PH_L2_GKV, PH_L2_ATT, PH_L2_GOUT,
       PH_L3_ROW, PH_L3_GIN, PH_L3_ATT, PH_L3_GOUT, PH_FIN, NPH };

struct EpiRoute {
    static constexpr bool PERM = false, AFTER_DRAIN = false;
    int ph; unsigned char* ws; int kq;
    __device__ __forceinline__ void operator()(const pg8::f32x4 (&acc)[2][2][4][2], const pg8::Unit& u, int wr, int wc, int fr, int fq) const {
        int ph_ = ph; asm volatile("" : "+s"(ph_));
        constexpr int BIG = 1 << 29;
        bf16_t* Qb = (bf16_t*)(ws + OFF_Q); bf16_t* Kb = (bf16_t*)(ws + OFF_K); bf16_t* Vb = (bf16_t*)(ws + OFF_V); bf16_t* Gb = (bf16_t*)(ws + OFF_G);
        int c1 = BIG, c2 = BIG, c3 = BIG, ld0 = 2048, ld1 = 2048, ld2 = 2048, ld3 = 2048, rope0 = 0, rope1 = 0, nvalid = BIG, mode = 0;
        bf16_t *d0 = Qb, *d1 = Qb, *d2 = Qb, *d3 = Qb;
        float qs0 = 1.f;
        if (ph_ == PH_L0_GIN || ph_ == PH_L3_GIN) { c1 = 2048; c2 = 4096; c3 = 6144; d1 = Kb; d2 = Vb; d3 = Gb; rope0 = rope1 = 1; qs0 = 0.125f * 1.4426950408889634f; }
        else if (ph_ == PH_L1_GIN) { c1 = 2048; c2 = 2560; c3 = 3072; d1 = Kb; ld1 = 512; d2 = Vb; ld2 = 512; d3 = Gb; }
        else if (ph_ == PH_L2_GIN) { d0 = Vb; ld0 = 1088; c1 = 1088; d1 = Gb; nvalid = 3136; }
        else if (ph_ == PH_L2_GQ) { ld0 = 3072; rope0 = 2; }
        else if (ph_ == PH_L2_GKV) { mode = 1; d0 = Kb; d1 = Vb; }
        else if (kq >= 0) { mode = 2; d0 = Vb + (size_t)kq * 2048 * 2048; }
        const int tb = u.pm % 9; const bool lat = tb < 8;
        float invf[4];
#pragma unroll
        for (int e = 0; e < 4; ++e) invf[e] = __builtin_amdgcn_exp2f(-(float)(4 * fq + e) * (13.287712379549449f / 16.f));
#pragma unroll
        for (int bj = 0; bj < 2; ++bj) {
            const int c0 = u.pn * 256 + bj * 128 + wc * 32;
            if (c0 >= nvalid) continue;
            bf16_t* dst; int ld, cl, rope; float scl = 1.f;
            if (mode == 1) { dst = bj ? d1 : d0; ld = 2048; cl = u.pn * 128 + wc * 32; rope = 0; }
            else if (c0 >= c3) { dst = d3; ld = ld3; cl = c0 - c3; rope = 0; }
            else if (c0 >= c2) { dst = d2; ld = ld2; cl = c0 - c2; rope = 0; }
            else if (c0 >= c1) { dst = d1; ld = ld1; cl = c0 - c1; rope = rope1; }
            else { dst = d0; ld = ld0; cl = c0; rope = rope0; scl = qs0; }
            const bool rp = lat && (rope == 1 || (rope == 2 && (c0 % 192) >= 128));
            const int par = (c0 >> 5) & 1;
            dst += cl + 4 * fq;
#pragma unroll
            for (int ai = 0; ai < 2; ++ai)
#pragma unroll
                for (int m = 0; m < 4; ++m) {
                    const size_t row = (mode == 2 ? (size_t)(u.pm / 9) * 256 : (size_t)u.pm * 256) + ai * 128 + wr * 64 + m * 16 + fr;
                    pg8::f32x4 v0 = acc[ai][bj][m][0] * scl, v1 = acc[ai][bj][m][1] * scl;
                    if (rp) {
                        const float pos = par ? (float)(16 * m + fr) : (float)(tb * 4 + 2 * ai + wr);
#pragma unroll
                        for (int e = 0; e < 4; ++e) { const float ang = pos * invf[e]; const float sn = __sinf(ang), cs = __cosf(ang);
                            const float a = v0[e], b = v1[e]; v0[e] = a * cs - b * sn; v1[e] = a * sn + b * cs; }
                    }
                    v2u w0, w1; w0.x = pg8::cvt_pk_bf16(v0[0], v0[1]); w0.y = pg8::cvt_pk_bf16(v0[2], v0[3]); w1.x = pg8::cvt_pk_bf16(v1[0], v1[1]); w1.y = pg8::cvt_pk_bf16(v1[2], v1[3]);
                    bf16_t* p = dst + row * ld;
                    *(v2u*)p = w0; *(v2u*)(p + 16) = w1;
                }
        }
    }
};

#ifndef ATT_ASYM
#define ATT_ASYM 0
#endif
namespace att {
using bf16x8 = __attribute__((ext_vector_type(8))) short;
using s16x4  = __attribute__((ext_vector_type(4))) short;
using f32x16 = __attribute__((ext_vector_type(16))) float;
using u32x4  = __attribute__((ext_vector_type(4))) unsigned;
constexpr int NW = 8, QBLK = 32, KVBLK = 64;
constexpr float THR = 8.f;
constexpr int SHM_V = KVBLK * 128 * 2;
#define SBAR() __builtin_amdgcn_sched_barrier(0)
__device__ __forceinline__ int crow(int r, int hi) { return (r & 3) + 8 * (r >> 2) + 4 * hi; }
__device__ __forceinline__ unsigned cvtpk(float lo, float hi) { unsigned r; asm volatile("v_cvt_pk_bf16_f32 %0, %1, %2" : "=v"(r) : "v"(lo), "v"(hi)); return r; }
template <int DQK> struct Sc { static constexpr float SCALE = DQK == 64 ? 0.125f : (DQK == 128 ? 0.088388347648318440f : 0.072168783648703220f); };
template <int KW> __device__ __forceinline__ int kswz(int row, int colB) { return row * (KW * 2) + (colB ^ ((row & 7) << 4)); }

template <int DQK> __device__ __forceinline__ void partialSM(f32x16& p0, f32x16& p1, float& m_reg, float& mn, float& alpha) {
  constexpr float SCALE = Sc<DQK>::SCALE; constexpr float C = SCALE * 1.4426950408889634f;
  float pmax = p0[0];
#pragma unroll
  for (int r = 1; r < 16; ++r) pmax = fmaxf(pmax, p0[r]);
#pragma unroll
  for (int r = 0; r < 16; ++r) pmax = fmaxf(pmax, p1[r]);
  { auto rr = __builtin_amdgcn_permlane32_swap(__float_as_uint(pmax), __float_as_uint(pmax), false, false);
    pmax = fmaxf(__uint_as_float(rr[0]), __uint_as_float(rr[1])); }
  if (__builtin_expect(__all(pmax - m_reg <= THR / SCALE), 1)) { mn = m_reg; alpha = 1.f; }
  else { mn = fmaxf(m_reg, pmax); alpha = __builtin_amdgcn_exp2f((m_reg - mn) * C); m_reg = mn; }
  float mnC = -mn * C;
#pragma unroll
  for (int r = 0; r < 16; ++r) p0[r] = fmaf(p0[r], C, mnC);
#pragma unroll
  for (int r = 0; r < 16; ++r) p1[r] = fmaf(p1[r], C, mnC);
#pragma unroll
  for (int r = 0; r < 16; ++r) p0[r] = __builtin_amdgcn_exp2f(p0[r]);
}
constexpr float THRL = THR * 1.4426950408889634f;
template <bool FIRST> __device__ __forceinline__ void partialSM_ps(f32x16& p0, f32x16& p1, float& m_reg, float& alpha, f32x16& negm) {
  float pmax = p0[0];
#pragma unroll
  for (int r = 1; r < 16; ++r) pmax = fmaxf(pmax, p0[r]);
#pragma unroll
  for (int r = 0; r < 16; ++r) pmax = fmaxf(pmax, p1[r]);
  { auto rr = __builtin_amdgcn_permlane32_swap(__float_as_uint(pmax), __float_as_uint(pmax), false, false);
    pmax = fmaxf(__uint_as_float(rr[0]), __uint_as_float(rr[1])); }
  alpha = 1.f;
  if (FIRST || !__builtin_expect(__all(pmax <= THRL), 1)) {
    const float dl = FIRST ? pmax : fmaxf(pmax, 0.f); m_reg += dl;
#pragma unroll
    for (int r = 0; r < 16; ++r) { p0[r] -= dl; p1[r] -= dl; }
    if (!FIRST) alpha = __builtin_amdgcn_exp2f(-dl);
#pragma unroll
    for (int r = 0; r < 16; ++r) negm[r] = -m_reg;
    asm volatile("" : "+v"(negm));
  }
#pragma unroll
  for (int r = 0; r < 16; ++r) p0[r] = __builtin_amdgcn_exp2f(p0[r]);
}
__device__ __forceinline__ void finishSM(f32x16& p0, f32x16& p1, float alpha, float& l_reg, bf16x8& pa0, bf16x8& pa1, bf16x8& pa2, bf16x8& pa3) {
#pragma unroll
  for (int r = 0; r < 16; ++r) p1[r] = __builtin_amdgcn_exp2f(p1[r]);
  float ps = 0;
#pragma unroll
  for (int r = 0; r < 16; ++r) ps += p0[r];
#pragma unroll
  for (int r = 0; r < 16; ++r) ps += p1[r];
  { auto rr = __builtin_amdgcn_permlane32_swap(__float_as_uint(ps), __float_as_uint(ps), false, false);
    ps = __uint_as_float(rr[0]) + __uint_as_float(rr[1]); }
  l_reg = l_reg * alpha + ps;
#define PK4(P, BASE, OUT) do { unsigned a0 = cvtpk(P[BASE + 0], P[BASE + 1]), a1 = cvtpk(P[BASE + 2], P[BASE + 3]);   \
    unsigned b0 = cvtpk(P[BASE + 4], P[BASE + 5]), b1 = cvtpk(P[BASE + 6], P[BASE + 7]);                              \
    auto r0 = __builtin_amdgcn_permlane32_swap(a0, b0, false, false); auto r1 = __builtin_amdgcn_permlane32_swap(a1, b1, false, false); \
    u32x4 w = {r0[0], r1[0], r0[1], r1[1]}; OUT = *reinterpret_cast<bf16x8*>(&w); } while (0)
  PK4(p0, 0, pa0); PK4(p0, 8, pa1); PK4(p1, 0, pa2); PK4(p1, 8, pa3);
#undef PK4
}
template <int DQK, int KW, int QSP> __device__ __forceinline__ void qkt(f32x16& p0, f32x16& p1, const char* Ks, const int (&kb)[4], const bf16x8* qr, const char* qsp, const f32x16& cinit) {
  p0 = cinit; p1 = cinit;
  constexpr int N = DQK / 16;
#define KRD(d, lo) (*reinterpret_cast<const bf16x8*>(Ks + kb[(d) & 3] + ((d) >> 2) * 128 + ((lo) ? 0 : 32 * KW * 2)))
  bf16x8 f0[2], f1[2];
  f0[0] = KRD(0, 1); f1[0] = KRD(0, 0);
#pragma unroll
  for (int d0 = 0; d0 < N; ++d0) {
    if (d0 + 1 < N) { f0[(d0 + 1) & 1] = KRD(d0 + 1, 1); f1[(d0 + 1) & 1] = KRD(d0 + 1, 0); }
    __builtin_amdgcn_sched_barrier(0x406);
    bf16x8 qf;
    if constexpr (QSP > 0) { if (d0 >= N - QSP) qf = *reinterpret_cast<const bf16x8*>(qsp + (d0 - (N - QSP)) * 1024); else qf = qr[d0]; } else qf = qr[d0];
    p0 = __builtin_amdgcn_mfma_f32_32x32x16_bf16(f0[d0 & 1], qf, p0, 0, 0, 0);
    p1 = __builtin_amdgcn_mfma_f32_32x32x16_bf16(f1[d0 & 1], qf, p1, 0, 0, 0);
    __builtin_amdgcn_sched_barrier(0x406); }
#undef KRD
}
__device__ __forceinline__ int v_st(int k, int c) { const int kk = (k & ~0xC) | ((k & 4) << 1) | ((k & 8) >> 1); return ((kk >> 3) * 4 + (c >> 5)) * 512 + ((kk & 7) * 32 + (c & 31)) * 2; }
__device__ __forceinline__ int v_rd_base(int lane) { return ((lane & 3) << 3) | (((lane >> 2) & 3) << 6) | (((lane >> 4) & 1) << 5) | (((lane >> 5) & 1) << 8); }
constexpr int v_rd_off(int d0, int ks, int half) { return d0 * 512 + ks * 4096 + half * 2048; }
template <int OFF> __device__ __forceinline__ s16x4 tr_read(int vb) {
  s16x4 r; asm volatile("ds_read_b64_tr_b16 %0, %1 offset:%2" : "=&v"(r) : "v"(vb), "i"(OFF) : "memory"); return r;
}
template <int D0> __device__ __forceinline__ void pv_one(f32x16& od, int vb, bf16x8 pa0, bf16x8 pa1, bf16x8 pa2, bf16x8 pa3) {
  const s16x4 l0 = tr_read<v_rd_off(D0, 0, 0)>(vb), h0 = tr_read<v_rd_off(D0, 0, 1)>(vb), l1 = tr_read<v_rd_off(D0, 1, 0)>(vb), h1 = tr_read<v_rd_off(D0, 1, 1)>(vb);
  const s16x4 l2 = tr_read<v_rd_off(D0, 2, 0)>(vb), h2 = tr_read<v_rd_off(D0, 2, 1)>(vb), l3 = tr_read<v_rd_off(D0, 3, 0)>(vb), h3 = tr_read<v_rd_off(D0, 3, 1)>(vb);
  asm volatile("s_waitcnt lgkmcnt(0)" ::: "memory"); SBAR();
#define PK(L, H) (bf16x8){L[0], L[1], L[2], L[3], H[0], H[1], H[2], H[3]}
  od = __builtin_amdgcn_mfma_f32_32x32x16_bf16(pa0, PK(l0, h0), od, 0, 0, 0);
  od = __builtin_amdgcn_mfma_f32_32x32x16_bf16(pa1, PK(l1, h1), od, 0, 0, 0);
  od = __builtin_amdgcn_mfma_f32_32x32x16_bf16(pa2, PK(l2, h2), od, 0, 0, 0);
  od = __builtin_amdgcn_mfma_f32_32x32x16_bf16(pa3, PK(l3, h3), od, 0, 0, 0);
#undef PK
}
__device__ __forceinline__ void pv_d0(f32x16* o, int vb, bf16x8 pa0, bf16x8 pa1, bf16x8 pa2, bf16x8 pa3) {
  pv_one<0>(o[0], vb, pa0, pa1, pa2, pa3); pv_one<1>(o[1], vb, pa0, pa1, pa2, pa3); pv_one<2>(o[2], vb, pa0, pa1, pa2, pa3); pv_one<3>(o[3], vb, pa0, pa1, pa2, pa3);
}
struct VF { s16x4 l0, h0, l1, h1, l2, h2, l3, h3; };
template <int D0> __device__ __forceinline__ void vf_read(VF& f, int vb) {
  f.l0 = tr_read<v_rd_off(D0, 0, 0)>(vb); f.h0 = tr_read<v_rd_off(D0, 0, 1)>(vb); f.l1 = tr_read<v_rd_off(D0, 1, 0)>(vb); f.h1 = tr_read<v_rd_off(D0, 1, 1)>(vb);
  f.l2 = tr_read<v_rd_off(D0, 2, 0)>(vb); f.h2 = tr_read<v_rd_off(D0, 2, 1)>(vb); f.l3 = tr_read<v_rd_off(D0, 3, 0)>(vb); f.h3 = tr_read<v_rd_off(D0, 3, 1)>(vb);
}
__device__ __forceinline__ void vf_mma(f32x16& od, const VF& f, bf16x8 pa0, bf16x8 pa1, bf16x8 pa2, bf16x8 pa3) {
#define PK(L, H) (bf16x8){L[0], L[1], L[2], L[3], H[0], H[1], H[2], H[3]}
  od = __builtin_amdgcn_mfma_f32_32x32x16_bf16(pa0, PK(f.l0, f.h0), od, 0, 0, 0);
  od = __builtin_amdgcn_mfma_f32_32x32x16_bf16(pa1, PK(f.l1, f.h1), od, 0, 0, 0);
  od = __builtin_amdgcn_mfma_f32_32x32x16_bf16(pa2, PK(f.l2, f.h2), od, 0, 0, 0);
  od = __builtin_amdgcn_mfma_f32_32x32x16_bf16(pa3, PK(f.l3, f.h3), od, 0, 0, 0);
#undef PK
}
__device__ __forceinline__ void pv_d0_pipe(f32x16* o, int vb, bf16x8 pa0, bf16x8 pa1, bf16x8 pa2, bf16x8 pa3) {
  VF fa, fb;
  SBAR(); vf_read<0>(fa, vb); vf_read<1>(fb, vb);
  asm volatile("s_waitcnt lgkmcnt(8)" ::: "memory"); SBAR(); vf_mma(o[0], fa, pa0, pa1, pa2, pa3); SBAR();
  vf_read<2>(fa, vb); asm volatile("s_waitcnt lgkmcnt(8)" ::: "memory"); SBAR(); vf_mma(o[1], fb, pa0, pa1, pa2, pa3); SBAR();
  vf_read<3>(fb, vb); asm volatile("s_waitcnt lgkmcnt(8)" ::: "memory"); SBAR(); vf_mma(o[2], fa, pa0, pa1, pa2, pa3); SBAR();
  asm volatile("s_waitcnt lgkmcnt(0)" ::: "memory"); SBAR(); vf_mma(o[3], fb, pa0, pa1, pa2, pa3);
}

struct UnitP {
  const bf16_t* Qw;  int ldq;
  const bf16_t* K0;  int ldk0;
  const bf16_t* K1;  int ldk1;
  const bf16_t* Vh;  int ldv;
  const bf16_t* Gw;
  bf16_t* Ow;
  int nt;
  float lam, osc;
  const float* subg;
};

template <int DQK, int KW, bool DIFF, int SDEPTH, int QSP, int NBUF>
__device__ __forceinline__ void attn_unit(const UnitP& P, char* lds) {
  constexpr int SHM_K = KVBLK * KW * 2, NKC = KW / 64;
  const int tid = otid(), wid = tid >> 6, lane = tid & 63, r32 = lane & 31, hi = lane >> 5;
  char* V_lds = lds; char* K_lds = lds + NBUF * SHM_V;
  float* ws = (float*)(lds + NBUF * (SHM_V + SHM_K)) + wid * 64; float* li_l = ws; float* al_l = ws + 32;
  float m_reg = DIFF ? 0.f : -1e30f, l_reg = 0; f32x16 o[4] = {}; f32x16 negm = {}; if constexpr (DIFF) asm volatile("" : "+v"(negm));    constexpr int NQR = DQK / 16 - QSP; bf16x8 qr[NQR > 0 ? NQR : 1];
  char* qsp = lds + NBUF * (SHM_V + SHM_K) + 2048 + wid * (QSP * 1024) + lane * 16;
  const int coffB = DIFF ? (wid >> 2) * 128 : 0;
  { const bf16_t* Qp = P.Qw + (long)r32 * P.ldq + hi * 8;
#pragma unroll
    for (int d0 = 0; d0 < NQR; ++d0) qr[d0] = *reinterpret_cast<const bf16x8*>(Qp + d0 * 16);
#pragma unroll
    for (int d0 = NQR; d0 < DQK / 16; ++d0) *reinterpret_cast<bf16x8*>(qsp + (d0 - NQR) * 1024) = *reinterpret_cast<const bf16x8*>(Qp + d0 * 16); }
  const int sr = tid >> 4, sc = (tid & 15) * 8, vst0 = v_st(sr, sc), vst1 = v_st(32 + sr, sc);
  const int vb0 = (int)(uintptr_t)V_lds + v_rd_base(lane);
  int kb[4];
#pragma unroll
  for (int q = 0; q < 4; ++q) kb[q] = coffB + kswz<KW>(r32, q * 32 + hi * 16);
  const unsigned voff = (unsigned)(sr * P.ldv + sc) * 2u, koff = (unsigned)(sr * P.ldk0 + sc) * 2u, koff2 = (unsigned)((tid >> 3) * P.ldk1 + (tid & 7) * 8) * 2u;
  const int kdst0 = kswz<KW>(sr, sc * 2), kdst2 = kswz<KW>(tid >> 3, 256 + (tid & 7) * 16);
  struct { bf16x8 vs0, vs1, ks0, ks1, ks2; } sr_[SDEPTH];
#define SLOAD(i, t) do { const char* vt_ = (const char*)P.Vh + (size_t)(t) * (KVBLK * 2) * P.ldv; const char* kt_ = (const char*)P.K0 + (size_t)(t) * (KVBLK * 2) * P.ldk0; \
    sr_[i].vs0 = *reinterpret_cast<const bf16x8*>(vt_ + voff); sr_[i].vs1 = *reinterpret_cast<const bf16x8*>(vt_ + (size_t)64 * P.ldv + voff); \
    sr_[i].ks0 = *reinterpret_cast<const bf16x8*>(kt_ + koff); sr_[i].ks1 = *reinterpret_cast<const bf16x8*>(kt_ + (size_t)64 * P.ldk0 + koff); \
    if constexpr (KW == 192) sr_[i].ks2 = *reinterpret_cast<const bf16x8*>((const char*)P.K1 + (size_t)(t) * (KVBLK * 2) * P.ldk1 + koff2); } while (0)
#define SWRITE(b, i) do { *(bf16x8*)(V_lds + (b) * SHM_V + vst0) = sr_[i].vs0; *(bf16x8*)(V_lds + (b) * SHM_V + vst1) = sr_[i].vs1; \
    *(bf16x8*)(K_lds + (b) * SHM_K + kdst0) = sr_[i].ks0; *(bf16x8*)(K_lds + (b) * SHM_K + kdst0 + 32 * KW * 2) = sr_[i].ks1; \
    if constexpr (KW == 192) *(bf16x8*)(K_lds + (b) * SHM_K + kdst2) = sr_[i].ks2; } while (0)
#define SWAIT() do { if constexpr (SDEPTH == 2) { if constexpr (NKC == 2) asm volatile("s_waitcnt vmcnt(4)" ::: "memory"); else asm volatile("s_waitcnt vmcnt(5)" ::: "memory"); } \
    else asm volatile("s_waitcnt vmcnt(0)" ::: "memory"); } while (0)
#define RESC(a) do { if (__any((a) < 1.f)) { if (hi == 0) al_l[r32] = (a); asm volatile("s_waitcnt lgkmcnt(0)" ::: "memory"); \
    _Pragma("unroll") for (int d = 0; d < 4; ++d) _Pragma("unroll") for (int r = 0; r < 16; ++r) o[d][r] *= al_l[crow(r, hi)]; } } while (0)
#define PVD0(...) do { pv_d0(__VA_ARGS__); } while (0)
#define PSM(X0, X1, MN, AL, FIRST) do { if constexpr (DIFF) partialSM_ps<FIRST>(X0, X1, m_reg, AL, negm); else partialSM<DQK>(X0, X1, m_reg, MN, AL); } while (0)
  f32x16 pA0, pA1, pB0, pB1; float mnA, mnB, alA, alB; bf16x8 pa0, pa1, pa2, pa3; const int NT = P.nt;
  if constexpr (NBUF == 3) {
#define VM0() asm volatile("s_waitcnt vmcnt(0)" ::: "memory")
#define WGBAR() asm volatile("s_waitcnt lgkmcnt(0)\n\ts_barrier" ::: "memory")
#define RSTEP(C0, C1, MNC, ALC, P0, P1, ALP, WR, LD, TNEXT2) do { \
      SBAR(); qkt<DQK, KW, QSP>(C0, C1, K_lds + rcur * SHM_K, kb, qr, qsp, negm); \
      finishSM(P0, P1, ALP, l_reg, pa0, pa1, pa2, pa3); SBAR(); \
      if (WR) { VM0(); SWRITE(rnext, 0); } if (LD) SLOAD(0, (TNEXT2)); SBAR(); \
      PVD0(o, vb0 + rprev * SHM_V, pa0, pa1, pa2, pa3); PSM(C0, C1, MNC, ALC, false); \
      WGBAR(); RESC(ALC); \
      rprev = rcur; rcur = rnext; rnext = (rnext == 2) ? 0 : rnext + 1; } while (0)
    int rprev = 0, rcur = 1, rnext = 2;
    SLOAD(0, 0); VM0(); SWRITE(0, 0); SLOAD(0, 1); WGBAR();
    qkt<DQK, KW, QSP>(pA0, pA1, K_lds, kb, qr, qsp, negm); PSM(pA0, pA1, mnA, alA, true);
    VM0(); SWRITE(1, 0); if (2 < NT) SLOAD(0, 2); WGBAR();
    for (int j = 1; j + 1 < NT; j += 2) {
      RSTEP(pB0, pB1, mnB, alB, pA0, pA1, alA, true, true, j + 2);
      RSTEP(pA0, pA1, mnA, alA, pB0, pB1, alB, true, (j + 3 < NT), j + 3);
    }
    RSTEP(pB0, pB1, mnB, alB, pA0, pA1, alA, false, false, 0);
    finishSM(pB0, pB1, alB, l_reg, pa0, pa1, pa2, pa3); SBAR();
    PVD0(o, vb0 + rprev * SHM_V, pa0, pa1, pa2, pa3);
#undef RSTEP
#undef VM0
#undef WGBAR
  } else {
  constexpr int SE = 0, SO = SDEPTH - 1;
  SLOAD(SE, 0); asm volatile("s_waitcnt vmcnt(0)" ::: "memory"); SWRITE(0, SE); __syncthreads();
  qkt<DQK, KW, QSP>(pA0, pA1, K_lds, kb, qr, qsp, negm); PSM(pA0, pA1, mnA, alA, true);
  SLOAD(SO, 1); if constexpr (SDEPTH == 2) { if (2 < NT) SLOAD(SE, 2); }
  SWAIT(); SWRITE(1, SO); __syncthreads();
  if (ATT_ASYM == 0 || wid < 4) {
  for (int j = 1; j + 1 < NT; j += 2) {
    SBAR(); qkt<DQK, KW, QSP>(pB0, pB1, K_lds + SHM_K, kb, qr, qsp, negm);
    finishSM(pA0, pA1, alA, l_reg, pa0, pa1, pa2, pa3); SBAR();
    SLOAD(SO, (j + SDEPTH)); SBAR();
    PVD0(o, vb0, pa0, pa1, pa2, pa3); PSM(pB0, pB1, mnB, alB, false);
    __syncthreads(); SWAIT(); SWRITE(0, SE);
    RESC(alB); __syncthreads();
    SBAR(); qkt<DQK, KW, QSP>(pA0, pA1, K_lds, kb, qr, qsp, negm);
    finishSM(pB0, pB1, alB, l_reg, pa0, pa1, pa2, pa3); SBAR();
    if (SDEPTH == 1 || j + 3 < NT) SLOAD(SE, (j + 1 + SDEPTH)); SBAR();
    PVD0(o, vb0 + SHM_V, pa0, pa1, pa2, pa3); PSM(pA0, pA1, mnA, alA, false);
    __syncthreads(); SWAIT(); SWRITE(1, SO);
    RESC(alA); __syncthreads();
  }
  } else {
  for (int j = 1; j + 1 < NT; j += 2) {
    SBAR(); finishSM(pA0, pA1, alA, l_reg, pa0, pa1, pa2, pa3); SBAR();
    qkt<DQK, KW, QSP>(pB0, pB1, K_lds + SHM_K, kb, qr, qsp, negm); SBAR();
    SLOAD(SO, (j + SDEPTH)); SBAR();
    PSM(pB0, pB1, mnB, alB, false); SBAR();
    PVD0(o, vb0, pa0, pa1, pa2, pa3);
    __syncthreads(); SWAIT(); SWRITE(0, SE);
    RESC(alB); __syncthreads();
    SBAR(); finishSM(pB0, pB1, alB, l_reg, pa0, pa1, pa2, pa3); SBAR();
    qkt<DQK, KW, QSP>(pA0, pA1, K_lds, kb, qr, qsp, negm); SBAR();
    if (SDEPTH == 1 || j + 3 < NT) SLOAD(SE, (j + 1 + SDEPTH)); SBAR();
    PSM(pA0, pA1, mnA, alA, false); SBAR();
    PVD0(o, vb0 + SHM_V, pa0, pa1, pa2, pa3);
    __syncthreads(); SWAIT(); SWRITE(1, SO);
    RESC(alA); __syncthreads();
  }
  }
  SBAR(); qkt<DQK, KW, QSP>(pB0, pB1, K_lds + SHM_K, kb, qr, qsp, negm);
  finishSM(pA0, pA1, alA, l_reg, pa0, pa1, pa2, pa3); SBAR();
  PVD0(o, vb0, pa0, pa1, pa2, pa3); PSM(pB0, pB1, mnB, alB, false);
  __syncthreads(); RESC(alB);
  finishSM(pB0, pB1, alB, l_reg, pa0, pa1, pa2, pa3); SBAR();
  PVD0(o, vb0 + SHM_V, pa0, pa1, pa2, pa3);
  }
  if (hi == 0) li_l[r32] = l_reg; asm volatile("s_waitcnt lgkmcnt(0)" ::: "memory");
  float rli[16];
#pragma unroll
  for (int r = 0; r < 16; ++r) rli[r] = __builtin_amdgcn_rcpf(li_l[crow(r, hi)]);
#pragma unroll
  for (int d0 = 0; d0 < 4; ++d0)
#pragma unroll
    for (int r = 0; r < 16; ++r) o[d0][r] *= rli[r];
  constexpr bool OUT_ALIAS = (QSP > 0) || (NBUF == 3);
  bf16_t* stg = (bf16_t*)(lds + (OUT_ALIAS ? 0 : NBUF * (SHM_V + SHM_K) + 2048)) + wid * 4096;
#define GATE_STORE() do { asm volatile("s_waitcnt lgkmcnt(0)" ::: "memory"); \
    _Pragma("unroll") for (int i_ = 0; i_ < 8; ++i_) { const int idx_ = i_ * 64 + lane, row_ = idx_ >> 4, ch_ = idx_ & 15; \
      const u32x4 ov_ = *(const u32x4*)(stg + row_ * 128 + ch_ * 8); const u32x4 gv_ = *(const u32x4*)(P.Gw + (long)row_ * 2048 + ch_ * 8); u32x4 w_; \
      _Pragma("unroll") for (int q_ = 0; q_ < 4; ++q_) w_[q_] = pk2(bflo(ov_[q_]) * silu_f(bflo(gv_[q_])), bfhi(ov_[q_]) * silu_f(bfhi(gv_[q_]))); \
      *(u32x4*)(P.Ow + (long)row_ * 2048 + ch_ * 8) = w_; } } while (0)
  if constexpr (!DIFF) {
    if constexpr (OUT_ALIAS) __syncthreads();
#pragma unroll
    for (int r = 0; r < 16; ++r) { const int ro = crow(r, hi) * 128 + r32;
#pragma unroll
      for (int d0 = 0; d0 < 4; ++d0) stg[ro + d0 * 32] = (bf16_t)f2bf(o[d0][r]); }
    GATE_STORE();
    __syncthreads();
  } else {
    __syncthreads();
    float* st = (float*)lds + (wid & 3) * 4096 + lane;
    if (wid >= 4) {
#pragma unroll
      for (int d0 = 0; d0 < 4; ++d0)
#pragma unroll
        for (int r = 0; r < 16; ++r) st[(d0 * 16 + r) * 64] = o[d0][r];
    }
    __syncthreads();
    if (wid < 4) {
      if constexpr (OUT_ALIAS) stg = (bf16_t*)(lds + 65536) + wid * 4096;
      float sg[4];
#pragma unroll
      for (int d0 = 0; d0 < 4; ++d0) sg[d0] = P.subg[d0 * 32 + r32] * P.osc;
#pragma unroll
      for (int r = 0; r < 16; ++r) { float ss = 0.f;
#pragma unroll
        for (int d0 = 0; d0 < 4; ++d0) { const float v = o[d0][r] - P.lam * st[(d0 * 16 + r) * 64]; o[d0][r] = v; ss += v * v; }
        ss += __shfl_xor(ss, 1); ss += __shfl_xor(ss, 2); ss += __shfl_xor(ss, 4); ss += __shfl_xor(ss, 8); ss += __shfl_xor(ss, 16);
        const float rstd = __builtin_amdgcn_rsqf(ss * (1.f / 128.f) + NORM_EPS); const int ro = crow(r, hi) * 128 + r32;
#pragma unroll
        for (int d0 = 0; d0 < 4; ++d0) stg[ro + d0 * 32] = (bf16_t)f2bf(o[d0][r] * rstd * sg[d0]); }
      GATE_STORE();
    }
    __syncthreads();
  }
#undef GATE_STORE
#undef PVD0
#undef PSM
#undef SLOAD
#undef SWRITE
#undef SWAIT
#undef RESC
}
#undef SBAR
}

struct KArgs { const float* in[44]; float* out; unsigned char* ws; int ph_lo, ph_hi; };

#define PICK4(l, a, b, c, d) ((l) == 0 ? (a) : (l) == 1 ? (b) : (l) == 2 ? (c) : (d))

__device__ __forceinline__ void p0_transpose_item(const float* W, int K, int N, bf16_t* WT, LAS float* scr, int item, int lane) {
    const int nblk = N / 32, kb = item / nblk, nb = item % nblk, k0 = 64 * kb, n0 = 32 * nb;
#pragma unroll 8
    for (int i = 0; i < 32; ++i) { const int kk = 2 * i + (lane >> 5); scr[kk * 33 + (lane & 31)] = W[(size_t)(k0 + kk) * N + n0 + (lane & 31)]; }
    LDS_WAIT(); asm volatile("" ::: "memory");
    const int c = lane & 7;
#pragma unroll
    for (int j = 0; j < 4; ++j) { const int n = (lane >> 3) + 8 * j; const LAS float* s = scr + (8 * c) * 33 + n;
        v4u o; o.x = pk2(s[0 * 33], s[1 * 33]); o.y = pk2(s[2 * 33], s[3 * 33]); o.z = pk2(s[4 * 33], s[5 * 33]); o.w = pk2(s[6 * 33], s[7 * 33]);
        *(GAS v4u*)(WT + (size_t)(n0 + n) * K + k0 + 8 * c) = o; }
    LDS_WAIT(); asm volatile("" ::: "memory");
}

__device__ __forceinline__ void convert_layer_weights(const KArgs& A, int l, LAS unsigned char* lds, int wave, int lane) {
    const int gw = blockIdx.x * NWAVES + wave, NGW = gridDim.x * NWAVES;
    LAS float* scr = (LAS float*)(lds + 73728 + wave * 8448);
    const int Nin = l == 1 ? 5120 : (l == 2 ? 3136 : 8192), Iin = 32 * (Nin / 32);
    constexpr int IO = 32 * 64, IQ = 8 * 96, IKV = 8 * 128;
    const int nitems = Iin + IO + (l == 2 ? IQ + IKV : 0);
    const float* win = PICK4(l, A.in[8], A.in[19], A.in[27], A.in[37]); const float* wout = PICK4(l, A.in[14], A.in[22], A.in[32], A.in[43]);
    for (int it = gw; it < nitems; it += NGW) {
        int r = it;
        if (r < Iin) { p0_transpose_item(win, 2048, Nin, (bf16_t*)(A.ws + OFF_WIN), scr, r, lane); continue; } r -= Iin;
        if (r < IO) { p0_transpose_item(wout, 2048, 2048, (bf16_t*)(A.ws + OFF_WOUT), scr, r, lane); continue; } r -= IO;
        if (r < IQ) { p0_transpose_item(A.in[29], 512, 3072, (bf16_t*)(A.ws + OFF_WQB), scr, r, lane); continue; } r -= IQ;
        p0_transpose_item(A.in[31], 512, 4096, (bf16_t*)(A.ws + OFF_WKVB), scr, r, lane);
    }
    if (l == 2) {
        v4u* z = (v4u*)((bf16_t*)(A.ws + OFF_WIN) + (size_t)3136 * 2048); const int n16 = 192 * 2048 * 2 / 16;
        for (int i = blockIdx.x * 512 + otid(); i < n16; i += gridDim.x * 512) z[i] = (v4u){0u, 0u, 0u, 0u}; }
}

__device__ __forceinline__ void phase_prologue(const KArgs& A, LAS unsigned char* lds, int wave, int lane) {
    LAS float* sl = (LAS float*)lds;
    for (int i = otid(); i < 9 * 2048; i += 512) { const int v = i >> 11, k = i & 2047; const float x = v < 8 ? A.in[1][v * 2048 + k] : A.in[3][k]; sl[i] = silu_f(x); }
    __syncthreads();
    const int gw = blockIdx.x * NWAVES + wave, NGW = gridDim.x * NWAVES;
    float* part = (float*)(A.ws + OFF_G);
    for (int task = gw; task < 4 * 24 * ADA_SPLIT; task += NGW) {
        const int l = task / (24 * ADA_SPLIT), rem = task % (24 * ADA_SPLIT), cgp = rem / ADA_SPLIT, s = rem % ADA_SPLIT;
        constexpr int KS = 2048 / ADA_SPLIT;
        const float* W = PICK4(l, A.in[4], A.in[15], A.in[23], A.in[33]) + (size_t)(s * KS) * 6144 + cgp * 256 + lane * 4;
        f32x4 acc[9];
#pragma unroll
        for (int v = 0; v < 9; ++v) acc[v] = (f32x4){0.f, 0.f, 0.f, 0.f};
        for (int k0 = 0; k0 < KS; k0 += 8) {
            f32x4 w[8];
#pragma unroll
            for (int i = 0; i < 8; ++i) w[i] = *(const f32x4*)(W + (size_t)(k0 + i) * 6144);
#pragma unroll
            for (int i = 0; i < 8; ++i)
#pragma unroll
                for (int v = 0; v < 9; ++v) acc[v] += w[i] * sl[v * 2048 + s * KS + k0 + i];
        }
#pragma unroll
        for (int v = 0; v < 9; ++v) *(f32x4*)(part + ((size_t)(s * 4 + l) * 9 + v) * 6144 + cgp * 256 + lane * 4) = acc[v];
    }
    convert_layer_weights(A, 0, lds, wave, lane);
}

__device__ __forceinline__ void phase_ada_reduce(const KArgs& A) {
    const float* part = (const float*)(A.ws + OFF_G); float* ada = (float*)(A.ws + OFF_ADA);
    constexpr int NTOT = 4 * 9 * 6144;
    for (int i = blockIdx.x * 512 + otid(); i < NTOT; i += gridDim.x * 512) {
        const int l = i / (9 * 6144), c = i % 6144;
        float s = PICK4(l, A.in[5], A.in[16], A.in[24], A.in[34])[c];
#pragma unroll
        for (int k = 0; k < ADA_SPLIT; ++k) s += part[(size_t)k * NTOT + i];
        ada[i] = s;
    }
}

__device__ __forceinline__ void phase_rowpass(const KArgs& A, int l, int wave, int lane, bool dummy = false) {
    const bool first = (l == 0), last = (l == 4);
    const int gw = blockIdx.x * NWAVES + wave, NGW = gridDim.x * NWAVES;
    const float* ada = (const float*)(A.ws + OFF_ADA);
    const int lp = l - 1;
    const float* post_g = first ? nullptr : PICK4(lp, A.in[7], A.in[18], A.in[26], A.in[36]);
    const float* pre_g = last ? nullptr : PICK4(l, A.in[6], A.in[17], A.in[25], A.in[35]);
    const bf16_t* Y = (const bf16_t*)(A.ws + OFF_Q); bf16_t* XN = (bf16_t*)(A.ws + (dummy ? OFF_G : OFF_XN)); bf16_t* HB = (bf16_t*)(A.ws + OFF_HB);
    for (int r = gw; r < MROWS; r += NGW) {
        const int b = r / TB, t = r % TB; const bool lat = t < SEQ; const int v = lat ? b : 8;
        if (last && !lat) continue;
        const size_t hoff = lat ? ((size_t)b * SEQ + t) * DM : ((size_t)b * CTXL + (t - SEQ)) * DM;
        f32x4 h[8];
        if (l <= 1) { const float* hin = (lat ? A.in[0] : A.in[2]) + hoff;
#pragma unroll
            for (int j = 0; j < 8; ++j) h[j] = *(const f32x4*)(hin + 4 * lane + 256 * j); }
        else {
#pragma unroll
            for (int j = 0; j < 8; ++j) { const v2u w = *(const v2u*)(HB + (size_t)r * DM + 4 * lane + 256 * j); h[j] = (f32x4){bflo(w.x), bfhi(w.x), bflo(w.y), bfhi(w.y)}; } }
        if (!first) {
            f32x4 y[8]; float ss = 0.f;
#pragma unroll
            for (int j = 0; j < 8; ++j) {
                if (lat || !GOUT_SPLIT) { const v2u w = *(const v2u*)(Y + (size_t)r * DM + 4 * lane + 256 * j); y[j] = (f32x4){bflo(w.x), bfhi(w.x), bflo(w.y), bfhi(w.y)}; }
                else { y[j] = (f32x4){0.f, 0.f, 0.f, 0.f};
#pragma unroll
                    for (int kq = 0; kq < 4; ++kq) { const v2u w = *(const v2u*)((const bf16_t*)(A.ws + OFF_V) + ((size_t)kq * 2048 + (size_t)b * CTXL + (t - SEQ)) * DM + 4 * lane + 256 * j);
                        y[j] += (f32x4){bflo(w.x), bfhi(w.x), bflo(w.y), bfhi(w.y)}; } }
                ss += (y[j].x * y[j].x + y[j].y * y[j].y) + (y[j].z * y[j].z + y[j].w * y[j].w); }
            const float rstd = 1.f / sqrtf(wave_sum(ss) * (1.f / DM) + NORM_EPS);
            const float* gate = ada + ((size_t)lp * 9 + v) * 6144 + 4096;
#pragma unroll
            for (int j = 0; j < 8; ++j) { const int c = 4 * lane + 256 * j; const f32x4 gt = *(const f32x4*)(gate + c), pg = *(const f32x4*)(post_g + c);
                h[j] += gt * (y[j] * rstd * pg);
                if (last) *(f32x4*)(A.out + hoff + c) = h[j];
                else { v2u w; w.x = pk2(h[j].x, h[j].y); w.y = pk2(h[j].z, h[j].w); *(v2u*)((dummy ? (bf16_t*)(A.ws + OFF_K) : HB) + (size_t)r * DM + c) = w; } }
        }
        if (!last) {
            float ss = 0.f;
#pragma unroll
            for (int j = 0; j < 8; ++j) ss += (h[j].x * h[j].x + h[j].y * h[j].y) + (h[j].z * h[j].z + h[j].w * h[j].w);
            const float rstd = 1.f / sqrtf(wave_sum(ss) * (1.f / DM) + NORM_EPS);
            const float* shift = ada + ((size_t)l * 9 + v) * 6144; const float* scale = shift + 2048;
#pragma unroll
            for (int j = 0; j < 8; ++j) { const int c = 4 * lane + 256 * j; const f32x4 sh = *(const f32x4*)(shift + c), sc = *(const f32x4*)(scale + c), pg = *(const f32x4*)(pre_g + c);
                const f32x4 x = (h[j] * rstd * pg) * (sc + 1.f) + sh; v2u w; w.x = pk2(x.x, x.y); w.y = pk2(x.z, x.w);
                *(v2u*)(XN + (size_t)r * DM + c) = w; }
        }
    }
}

__device__ __forceinline__ void nr128(bf16_t* p, const float* g, bool lat, int t, int qd) {
    const int half = qd >> 1, jh = qd & 1, d0 = 64 * half + 16 * jh;
    v4u a0 = *(const v4u*)(p + d0), a1 = *(const v4u*)(p + d0 + 8), b0 = *(const v4u*)(p + d0 + 32), b1 = *(const v4u*)(p + d0 + 40);
    float xa[16], xb[16];
#pragma unroll
    for (int i = 0; i < 4; ++i) { xa[2 * i] = bflo(a0[i]); xa[2 * i + 1] = bfhi(a0[i]); xa[8 + 2 * i] = bflo(a1[i]); xa[8 + 2 * i + 1] = bfhi(a1[i]);
        xb[2 * i] = bflo(b0[i]); xb[2 * i + 1] = bfhi(b0[i]); xb[8 + 2 * i] = bflo(b1[i]); xb[8 + 2 * i + 1] = bfhi(b1[i]); }
    float ss = 0.f;
#pragma unroll
    for (int i = 0; i < 16; ++i) ss += xa[i] * xa[i] + xb[i] * xb[i];
    ss += __shfl_xor(ss, 1); ss += __shfl_xor(ss, 2);
    const float rstd = 1.f / sqrtf(ss * (1.f / 128.f) + NORM_EPS);
    const float pos = half ? (float)(t & 63) : (float)(t >> 6);
#pragma unroll
    for (int i = 0; i < 16; ++i) { float x1 = xa[i] * rstd * g[d0 + i], x2 = xb[i] * rstd * g[d0 + 32 + i];
        if (lat) { const float ang = pos * __builtin_amdgcn_exp2f(-(float)(16 * jh + i) * (13.287712379549449f / 32.f)); const float sn = __sinf(ang), cs = __cosf(ang);
            const float o1 = x1 * cs - x2 * sn, o2 = x1 * sn + x2 * cs; x1 = o1; x2 = o2; }
        xa[i] = x1; xb[i] = x2; }
#pragma unroll
    for (int i = 0; i < 4; ++i) { a0[i] = pk2(xa[2 * i], xa[2 * i + 1]); a1[i] = pk2(xa[8 + 2 * i], xa[8 + 2 * i + 1]); b0[i] = pk2(xb[2 * i], xb[2 * i + 1]); b1[i] = pk2(xb[8 + 2 * i], xb[8 + 2 * i + 1]); }
    *(v4u*)(p + d0) = a0; *(v4u*)(p + d0 + 8) = a1; *(v4u*)(p + d0 + 32) = b0; *(v4u*)(p + d0 + 40) = b1;
}
__device__ __forceinline__ void phase_post_gqa(const KArgs& A, int wave, int lane) {
    const int gw = blockIdx.x * NWAVES + wave, NGW = gridDim.x * NWAVES;
    bf16_t* Q = (bf16_t*)(A.ws + OFF_Q); bf16_t* K = (bf16_t*)(A.ws + OFF_K);
    for (int r = gw; r < MROWS; r += NGW) { const int t = r % TB; const bool lat = t < SEQ;
        nr128(Q + (size_t)r * 2048 + (lane >> 2) * 128, A.in[20], lat, t, lane & 3);
        if (lane < 16) nr128(K + (size_t)r * 512 + (lane >> 2) * 128, A.in[21], lat, t, lane & 3); }
}
__device__ __forceinline__ void phase_post_mla(const KArgs& A, int wave, int lane) {
    const int gw = blockIdx.x * NWAVES + wave, NGW = gridDim.x * NWAVES;
    const bf16_t* RAW = (const bf16_t*)(A.ws + OFF_V); bf16_t* NQA = (bf16_t*)(A.ws + OFF_XN); bf16_t* NKVA = NQA + (size_t)MROWS * 512; bf16_t* KR = (bf16_t*)(A.ws + OFF_KR);
    for (int r = gw; r < MROWS; r += NGW) { const int t = r % TB; const bool lat = t < SEQ; const bf16_t* row = RAW + (size_t)r * 1088;
#pragma unroll
        for (int part = 0; part < 2; ++part) {
            const v4u w = *(const v4u*)(row + part * 512 + 8 * lane); float x[8]; float ss = 0.f;
#pragma unroll
            for (int i = 0; i < 4; ++i) { x[2 * i] = bflo(w[i]); x[2 * i + 1] = bfhi(w[i]); ss += x[2 * i] * x[2 * i] + x[2 * i + 1] * x[2 * i + 1]; }
            const float rstd = 1.f / sqrtf(wave_sum(ss) * (1.f / 512.f) + NORM_EPS);
            const float* g = (part ? A.in[30] : A.in[28]) + 8 * lane; v4u o;
#pragma unroll
            for (int i = 0; i < 4; ++i) o[i] = pk2(x[2 * i] * rstd * g[2 * i], x[2 * i + 1] * rstd * g[2 * i + 1]);
            *(v4u*)((part ? NKVA : NQA) + (size_t)r * 512 + 8 * lane) = o;
        }
        if (lane < 32) { const int half = lane >> 4, j = lane & 15; float x1 = bf1(row[1024 + 32 * half + j]), x2 = bf1(row[1024 + 32 * half + 16 + j]);
            if (lat) { const float pos = half ? (float)(t & 63) : (float)(t >> 6); const float ang = pos * __builtin_amdgcn_exp2f(-(float)j * (13.287712379549449f / 16.f));
                const float sn = __sinf(ang), cs = __cosf(ang); const float o1 = x1 * cs - x2 * sn, o2 = x1 * sn + x2 * cs; x1 = o1; x2 = o2; }
            KR[(size_t)r * 64 + 32 * half + j] = (bf16_t)f2bf(x1); KR[(size_t)r * 64 + 32 * half + 16 + j] = (bf16_t)f2bf(x2); }
    }
}

template <int DQK, int KW, bool DIFF, int SD, int QSP, int NBUF>
__device__ __forceinline__ void phase_attn(const KArgs& A, char* lds, int layer, bool need_ctx, int wave, int lane) {
    const bf16_t* Q = (const bf16_t*)(A.ws + OFF_Q); const bf16_t* K = (const bf16_t*)(A.ws + OFF_K); const bf16_t* V = (const bf16_t*)(A.ws + OFF_V);
    const bf16_t* G = (const bf16_t*)(A.ws + OFF_G); const bf16_t* KR = (const bf16_t*)(A.ws + OFF_KR); bf16_t* O = (bf16_t*)(A.ws + OFF_XN);
    float lam = 0.f, osc = 0.f; const float* subg = nullptr;
    if constexpr (DIFF) {
        const float* q1 = layer == 0 ? A.in[9] : A.in[38]; const float* k1 = layer == 0 ? A.in[10] : A.in[39];
        const float* q2 = layer == 0 ? A.in[11] : A.in[40]; const float* k2 = layer == 0 ? A.in[12] : A.in[41];
        const float linit = layer == 0 ? 0.2f : 0.55605820435704293f;
        lam = __expf(wave_sum(q1[lane] * k1[lane])) - __expf(wave_sum(q2[lane] * k2[lane])) + linit; osc = 1.f - linit;
        subg = layer == 0 ? A.in[13] : A.in[42];
    }
    constexpr int RPU = DIFF ? 128 : 256, UPB = SEQ / RPU, CPB = CTXL / RPU;
    const int nbig = NB * 16 * UPB, ntot = nbig + (need_ctx ? NB * 16 * CPB : 0);
    const int vcu = (gridDim.x % 8 == 0) ? (int)(blockIdx.x % 8) * (int)(gridDim.x / 8) + (int)(blockIdx.x / 8) : (int)blockIdx.x;
    for (int u = vcu; u < ntot; u += gridDim.x) {
        int bh, qrow, krow, nt;
        if (u < nbig) { bh = u / UPB; qrow = (u % UPB) * RPU; krow = 0; nt = TB / 64; }
        else { const int u2 = u - nbig; bh = u2 / CPB; qrow = SEQ + (u2 % CPB) * RPU; krow = SEQ; nt = CTXL / 64; }
        const int b = bh >> 4, h = bh & 15;
        const long r0 = (long)b * TB + qrow + (DIFF ? 32 * (wave & 3) : 32 * wave), k0 = (long)b * TB + krow;
        att::UnitP P;
        if constexpr (DIFF) { P.Qw = Q + r0 * 2048 + h * 128 + (wave >> 2) * 64; P.ldq = 2048; P.K0 = K + k0 * 2048 + h * 128; P.ldk0 = 2048; P.K1 = nullptr; P.ldk1 = 0; P.Vh = V + k0 * 2048 + h * 128; P.ldv = 2048; }
        else if constexpr (DQK == 128) { P.Qw = Q + r0 * 2048 + h * 128; P.ldq = 2048; P.K0 = K + k0 * 512 + (h >> 2) * 128; P.ldk0 = 512; P.K1 = nullptr; P.ldk1 = 0; P.Vh = V + k0 * 512 + (h >> 2) * 128; P.ldv = 512; }
        else { P.Qw = Q + r0 * 3072 + h * 192; P.ldq = 3072; P.K0 = K + k0 * 2048 + h * 128; P.ldk0 = 2048; P.K1 = KR + k0 * 64; P.ldk1 = 64; P.Vh = V + k0 * 2048 + h * 128; P.ldv = 2048; }
        P.Gw = G + r0 * 2048 + h * 128; P.Ow = O + r0 * 2048 + h * 128; P.nt = nt; P.lam = lam; P.osc = osc; P.subg = subg;
        att::attn_unit<DQK, KW, DIFF, SD, QSP, NBUF>(P, lds);
    }
}

#define XB_TMO      128
#define XB_XCNT(j)  (256  + 64 * (j))
#define XB_XSUB(j)  (1280 + 64 * (j))
#define XB_XGEN(j)  (2304 + 64 * (j))
#define XB_TOP      3328
#define XB_TOPGEN   3392
#define XCD_BAR_WORDS 3456
#define XB_SPIN_CAP (1u << 18)

__device__ __forceinline__ unsigned xb_ld(unsigned* p)              { return __hip_atomic_load(p, __ATOMIC_RELAXED, __HIP_MEMORY_SCOPE_AGENT); }
__device__ __forceinline__ unsigned xb_add(unsigned* p, unsigned v) { return __hip_atomic_fetch_add(p, v, __ATOMIC_RELAXED, __HIP_MEMORY_SCOPE_AGENT); }
__device__ __forceinline__ unsigned xb_xcc_id() { return (unsigned)__builtin_amdgcn_s_getreg((3 << 11) | 20) & 0xFu; }
#define XB_SPIN(cond, bar) do { unsigned _sp = 0; while (cond) { __builtin_amdgcn_s_sleep(1); \
    if ((++_sp & 255u) == 0u) { if (xb_ld(&(bar)[XB_TMO])) break; if (_sp > XB_SPIN_CAP) { atomicAdd(&(bar)[XB_TMO], 1u); break; } } } } while (0)

struct XcdBarrier {
    unsigned* bar; unsigned x;
    volatile LAS unsigned* st;
};

__device__ __forceinline__ XcdBarrier xcd_barrier_post(unsigned* bar, volatile LAS unsigned* st) {
    XcdBarrier b; b.bar = bar; b.x = xb_xcc_id(); b.st = st;
    if (threadIdx.x == 0) (void)xb_add(&bar[XB_XCNT(b.x)], 1u);
    return b;
}
__device__ __forceinline__ void xcd_barrier_complete(unsigned* bar, unsigned x, unsigned& nloc, unsigned& nx) {
    const unsigned G = gridDim.x * gridDim.y * gridDim.z;
    unsigned sum, cnt, mine, sp = 0u;
    for (;;) {
        sum = 0u; cnt = 0u; mine = 0u;
#pragma unroll
        for (unsigned j = 0; j < 16; ++j) { const unsigned c = xb_ld(&bar[XB_XCNT(j)]); sum += c; cnt += (c > 0u) ? 1u : 0u; mine = (j == x) ? c : mine; }
        if (sum == G) break;
        __builtin_amdgcn_s_sleep(1);
        if ((++sp & 255u) == 0u) { if (xb_ld(&bar[XB_TMO])) break; if (sp > XB_SPIN_CAP) { atomicAdd(&bar[XB_TMO], 1u); break; } }
    }
    nloc = mine > 0u ? mine : 1u; nx = cnt > 0u ? cnt : 1u;
}

__device__ __forceinline__ void xcd_barrier(const XcdBarrier& b) {
    asm volatile("s_waitcnt vmcnt(0)" ::: "memory");
    __syncthreads();
    if (threadIdx.x == 0) {
        unsigned* bar = b.bar;
        __builtin_amdgcn_s_waitcnt(0);
        unsigned nloc = b.st[0], nx = b.st[1];
        if (nloc == 0u) { xcd_barrier_complete(bar, b.x, nloc, nx); b.st[0] = nloc; b.st[1] = nx; }
        const unsigned old = xb_add(&bar[XB_XSUB(b.x)], 1u);
        const unsigned gen = old / nloc;
        if (old + 1u == (gen + 1u) * nloc) {
            __builtin_amdgcn_fence(__ATOMIC_RELEASE, "agent");
            asm volatile("s_waitcnt vmcnt(0)" ::: "memory");
            const unsigned og = xb_add(&bar[XB_TOP], 1u);
            const unsigned tg = og / nx;
            if (og + 1u == (tg + 1u) * nx) xb_add(&bar[XB_TOPGEN], 1u);
            else XB_SPIN(xb_ld(&bar[XB_TOPGEN]) == tg, bar);
            __builtin_amdgcn_fence(__ATOMIC_ACQUIRE, "agent");
            xb_add(&bar[XB_XGEN(b.x)], 1u);
            asm volatile("s_waitcnt vmcnt(0)" ::: "memory");
        } else {
            XB_SPIN(xb_ld(&bar[XB_XGEN(b.x)]) == gen, bar);
            __builtin_amdgcn_fence(__ATOMIC_ACQUIRE, "agent");
            asm volatile("s_waitcnt vmcnt(0)" ::: "memory");
        }
    }
    __syncthreads();
}

__global__ void __launch_bounds__(512) fwd_kernel(KArgs A0) {
    extern __shared__ __attribute__((aligned(16))) unsigned char lds[];
    cg::grid_group grid = cg::this_grid();
    LAS unsigned char* ldsl = (LAS unsigned char*)lds;
    volatile LAS unsigned* bst = (volatile LAS unsigned*)(ldsl + LDS_BYTES - 16);
    if (threadIdx.x < 4) bst[threadIdx.x] = 0u;
    __syncthreads();
    XcdBarrier xbar = xcd_barrier_post((unsigned*)(A0.ws + OFF_BAR), bst);
#ifndef REPMASK
#define REPMASK 0
#endif
    const int ph_lo = A0.ph_lo, ph_hi = A0.ph_hi;
    if (ph_lo < 0) grid.sync();
    for (int ph = ph_lo; ph < ph_hi; ++ph) {
      const bool is_att = (ph == PH_L0_ATT || ph == PH_L1_ATT || ph == PH_L2_ATT || ph == PH_L3_ATT);
      const bool is_gemm = (ph == PH_L0_GIN || ph == PH_L1_GIN || ph == PH_L2_GIN || ph == PH_L3_GIN || ph == PH_L0_GOUT || ph == PH_L1_GOUT || ph == PH_L2_GOUT || ph == PH_L3_GOUT || ph == PH_L2_GQ || ph == PH_L2_GKV);
      const int nrep = (((REPMASK & 1) && is_att) || ((REPMASK & 2) && is_gemm) || ((REPMASK & 4) && ph == PH_PRO) || ((REPMASK & 8) && ph == PH_L0_ATT) || ((REPMASK & 16) && ph == PH_L1_ATT) || ((REPMASK & 32) && ph == PH_L2_ATT) || ((REPMASK & 64) && ph == PH_L0_GIN) || ((REPMASK & 128) && ph == PH_L0_GOUT)) ? 2 : 1;
      for (int rp = 0; rp < nrep; ++rp) {
        if (rp) xcd_barrier(xbar);
        const int tid_ = otid(); const int lane = tid_ & 63, wave = __builtin_amdgcn_readfirstlane(tid_ >> 6);
        const KArgs __attribute__((address_space(4)))* ap_ = (const KArgs __attribute__((address_space(4)))*)__builtin_amdgcn_kernarg_segment_ptr();
        asm volatile("" : "+s"(ap_));
        const KArgs& A = *(const KArgs*)ap_;
        unsigned char* ws = A.ws;
#ifndef PM
#define PM 0xff
#endif
#ifndef ATT_NBUF
#define ATT_NBUF 3
#endif
#define ATT_SD0 (ATT_NBUF == 3 ? 1 : ATT_SD)
#ifndef ATT_SD
#define ATT_SD 2
#endif
        if (ph == PH_PRO) { if (PM & 1) phase_prologue(A, ldsl, wave, lane); }
        else if (ph == PH_ADA) phase_ada_reduce(A);
        else if (ph == PH_L0_ROW || ph == PH_L1_ROW || ph == PH_L2_ROW || ph == PH_L3_ROW || ph == PH_FIN)
            { if (REPMASK & 512) { phase_rowpass(A, ph == PH_L0_ROW ? 0 : ph == PH_L1_ROW ? 1 : ph == PH_L2_ROW ? 2 : ph == PH_L3_ROW ? 3 : 4, wave, lane, true); xcd_barrier(xbar); }
              if (ph == PH_L1_ROW || ph == PH_L2_ROW || ph == PH_L3_ROW) convert_layer_weights(A, ph == PH_L1_ROW ? 1 : ph == PH_L2_ROW ? 2 : 3, ldsl, wave, lane);
              if (PM & 2) phase_rowpass(A, ph == PH_L0_ROW ? 0 : ph == PH_L1_ROW ? 1 : ph == PH_L2_ROW ? 2 : ph == PH_L3_ROW ? 3 : 4, wave, lane); }
        else if (ph == PH_L1_POST) { if (PM & 4) phase_post_gqa(A, wave, lane); }
        else if (ph == PH_L2_POST) { if (PM & 4) phase_post_mla(A, wave, lane); }
        else if (ph == PH_L0_ATT || ph == PH_L3_ATT) { if (PM & 8) phase_attn<64, 128, true, ATT_SD0, 0, ATT_NBUF>(A, (char*)lds, ph == PH_L0_ATT ? 0 : 3, ph == PH_L0_ATT, wave, lane); }
        else if (ph == PH_L1_ATT) { if (PM & 16) phase_attn<128, 128, false, ATT_SD0, 4, ATT_NBUF>(A, (char*)lds, 1, true, wave, lane); }
        else if (ph == PH_L2_ATT) { if (PM & 32) phase_attn<192, 192, false, 1, 3, ATT_NBUF>(A, (char*)lds, 2, true, wave, lane); }
        else if (PM & 64) {
            bf16_t* XN = (bf16_t*)(ws + OFF_XN);
            const bool is_gout = (ph == PH_L0_GOUT || ph == PH_L1_GOUT || ph == PH_L2_GOUT || ph == PH_L3_GOUT);
            const int npass = (GOUT_SPLIT && is_gout && ph != PH_L3_GOUT) ? 2 : 1;
            for (int pass = 0; pass < npass; ++pass) {
            pg8::Gemm g; EpiRoute E; E.ph = ph; E.ws = ws; E.kq = -1;
            g.A = XN; g.M = MROWS; g.K = 2048; g.ld = 2048;
            if (ph == PH_L0_GIN || ph == PH_L3_GIN) { g.Bt = (const bf16_t*)(ws + OFF_WIN); g.N = 8192; }
            else if (ph == PH_L1_GIN) { g.Bt = (const bf16_t*)(ws + OFF_WIN); g.N = 5120; }
            else if (ph == PH_L2_GIN) { g.Bt = (const bf16_t*)(ws + OFF_WIN); g.N = 3328; }
            else if (ph == PH_L2_GQ) { g.K = 512; g.ld = 512; g.Bt = (const bf16_t*)(ws + OFF_WQB); g.N = 3072; }
            else if (ph == PH_L2_GKV) { g.A = XN + (size_t)MROWS * 512; g.K = 512; g.ld = 512; g.Bt = (const bf16_t*)(ws + OFF_WKVB); g.N = 4096; }
            else { const int l = ph == PH_L0_GOUT ? 0 : ph == PH_L1_GOUT ? 1 : ph == PH_L2_GOUT ? 2 : 3; g.Bt = (const bf16_t*)(ws + OFF_WOUT); g.N = 2048; (void)l; }
            pg8::StaticOrder S; S.init(g.M, g.N, (int)gridDim.x, (int)blockIdx.x);
            if (is_gout && (GOUT_SPLIT || ph == PH_L3_GOUT)) {
                if (pass == 0) { S.init(NB * SEQ, g.N, (int)gridDim.x, (int)blockIdx.x); S.skip9 = true; }
                else { const int c = (int)blockIdx.x, tq = c >> 2, kq = c & 3; S.one = true; S.opm = (tq >> 3) * 9 + 8; S.opn = tq & 7;
                    g.A += kq * 512; g.Bt += kq * 512; g.K = 512; E.kq = kq; }
            }
            pg8::gemm_phase<EpiRoute, pg8::StaticOrder, true, true>(ldsl, g, S, E);
            }
        }
      }
        if (ph + 1 < ph_hi && ph != PH_L2_GQ) xcd_barrier(xbar);
    }
    if (REPMASK & 256) { for (int i = 0; i < 20; ++i) xcd_barrier(xbar); }
}

#ifndef MK_ONE_LAUNCH
#define MK_ONE_LAUNCH 1
#endif
extern "C" void kernel_launch(void* const* d_in, const int* in_sizes, int n_in, void* d_out, int out_size, void* d_ws, size_t ws_size, hipStream_t stream) {
    static int grid = 0;
    if (grid == 0) {
        if (n_in != 44 || out_size != NB * SEQ * DM || ws_size < WS_END) { fprintf(stderr, "kernel_launch: unexpected shapes n_in %d out %d ws %zu (need %zu)\n", n_in, out_size, ws_size, (size_t)WS_END); grid = -1; return; }
        int dev = 0, cus = 0, per_cu = 0;
        hipGetDevice(&dev); hipDeviceGetAttribute(&cus, hipDeviceAttributeMultiprocessorCount, dev);
        if (hipFuncSetAttribute((const void*)fwd_kernel, hipFuncAttributeMaxDynamicSharedMemorySize, LDS_BYTES) != hipSuccess) { fprintf(stderr, "kernel_launch: hipFuncSetAttribute failed\n"); grid = -1; return; }
        if (hipOccupancyMaxActiveBlocksPerMultiprocessor(&per_cu, (const void*)fwd_kernel, 512, LDS_BYTES) != hipSuccess || per_cu < 1) { fprintf(stderr, "kernel_launch: occupancy query gave %d\n", per_cu); per_cu = 1; }
        (void)hipGetLastError();
        grid = cus * per_cu; if (grid > 256) grid = 256;
        fprintf(stderr, "kernel_launch: grid %d (cus %d x %d)\n", grid, cus, per_cu);
    }
    if (grid < 0) return;
    if (hipMemsetAsync((char*)d_ws + OFF_BAR, 0, 16384, stream) != hipSuccess) { fprintf(stderr, "kernel_launch: memset failed\n"); return; }
    KArgs a{};
    for (int i = 0; i < 44; ++i) a.in[i] = (const float*)d_in[i];
    a.out = (float*)d_out; a.ws = (unsigned char*)d_ws;
#if MK_ONE_LAUNCH
    a.ph_lo = 0; a.ph_hi = NPH;
    void* args[] = {&a};
    hipError_t e = hipLaunchCooperativeKernel((const void*)fwd_kernel, dim3(grid), dim3(512), args, LDS_BYTES, stream);
    if (e != hipSuccess) fprintf(stderr, "kernel_launch: cooperative launch failed: %s (grid %d)\n", hipGetErrorString(e), grid);
#else
    for (int ph = 0; ph < NPH; ++ph) { a.ph_lo = ph; a.ph_hi = ph + 1; hipLaunchKernelGGL(fwd_kernel, dim3(grid), dim3(512), LDS_BYTES, stream, a); }
#endif
}
```

```cpp
#include <hip/hip_runtime.h>
#include <hip/hip_cooperative_groups.h>
#include <cstdio>
#include <cstdint>
namespace cg = cooperative_groups;
#ifndef GOUT_SPLIT
#define GOUT_SPLIT 0
#endif
__device__ __forceinline__ int otid() { int t = threadIdx.x; asm volatile("" : "+v"(t)); return t; }
namespace pg8 {
#define PG8_LAS __attribute__((address_space(3)))
typedef unsigned short bf16_t;
typedef short bf16x8 __attribute__((ext_vector_type(8)));
typedef float f32x4 __attribute__((ext_vector_type(4)));
typedef unsigned u32x4 __attribute__((ext_vector_type(4)));
constexpr int BM = 256, BK = 64, HALF = 128, HTB = HALF * BK * 2  , STAGE_BYTES = 8 * HTB, NXCD = 8, WGM = 8;

__host__ __device__ __forceinline__ int lds_byte(int r, int c) { const int st = (r >> 4) * 2 + (c >> 5), rr = r & 15, cc = c & 31, ob = rr * 64 + cc * 2; return st * 1024 + (ob ^ (((ob >> 9) & 1) << 5)); }
__host__ __device__ __forceinline__ void stage_rc(int b, int& R, int& C) { const int st = b / 1024, sb = b % 1024, swz = sb ^ (((sb >> 9) & 1) << 5); R = (st >> 1) * 16 + swz / 64; C = (st & 1) * 32 + (swz % 64) / 2; }
__host__ __device__ __forceinline__ int perm32(int rho) { const int n = rho >> 4, i = rho & 15; return 8 * (i >> 2) + 4 * n + (i & 3); }

struct Unit { int pm, pn; };
struct Gemm { const bf16_t* A; const bf16_t* Bt; int M, N, K, ld; };

struct StaticOrder {
    int nM, nN, nwg, G, c; bool skip9 = false;
    __host__ __device__ void init(int M, int N, int G_, int c_) { nM = M / BM; nN = N / BM; nwg = nM * nN; G = G_; c = c_; }
    __host__ __device__ bool next(int i, Unit& u) const {
        const long L = (long)i * G + c; if (L >= nwg) return false;
        int wgid = (int)L; { const int q = nwg / NXCD, r = nwg % NXCD, xcd = wgid % NXCD, off = wgid / NXCD; wgid = (xcd < r ? xcd * (q + 1) : r * (q + 1) + (xcd - r) * q) + off; }
        const int nig = WGM * nN, gid = wgid / nig, fm = gid * WGM, gsz = (nM - fm) < WGM ? (nM - fm) : WGM;
        u.pm = fm + ((wgid % nig) % gsz); u.pn = (wgid % nig) / gsz; if (skip9) u.pm += u.pm >> 3; return true;
    }
    __device__ __forceinline__ void a_ready(const Unit&) const {}
    __device__ __forceinline__ void done(const Unit&) const {}
};
__device__ __forceinline__ unsigned cvt_pk_bf16(float lo, float hi) { unsigned r; asm volatile("v_cvt_pk_bf16_f32 %0, %1, %2" : "=v"(r) : "v"(lo), "v"(hi)); return r; }
template <class Epi, class Sched, bool ALIGN_EPI = false, bool SP2 = false>
__device__ __forceinline__ void gemm_phase(PG8_LAS unsigned char* lds, const Gemm g, const Sched& S, const Epi& E) {
    const int tid = otid(), wid = __builtin_amdgcn_readfirstlane(tid >> 6), lane = tid & 63, wr = wid >> 2, wc = wid & 3, fr = lane & 15, fq = lane >> 4;
    const int K = g.K, nt = K / BK, LD = g.ld;
    unsigned voffA[2], voffB[2];
#pragma unroll
    for (int i = 0; i < 2; ++i) { int R, C; stage_rc(tid * 16 + i * 8192, R, C); const int Rb = Epi::PERM ? ((R & ~31) + perm32(R & 31)) : R;
        voffA[i] = (unsigned)(R * LD + C) * 2u; voffB[i] = (unsigned)(Rb * LD + C) * 2u; }
    const size_t kstep = (size_t)(BK * 2);
    const size_t hstep = (size_t)HALF * LD * 2;
    const size_t tstep = 2 * hstep;
    const unsigned ldsw = (unsigned)wid * 1024u;
    const int aoff = lds_byte(wr * 64 + fr, fq * 8), boff = lds_byte(wc * 32 + fr, fq * 8);
#define PG8_SA(b, h) (((b) * 2 + (h)) * HTB)
#define PG8_SB(b, h) ((4 + (b) * 2 + (h)) * HTB)
#define PG8_STAGE(bufoff, gbase, voff) do { _Pragma("unroll") for (int _i = 0; _i < 2; ++_i) \
        __builtin_amdgcn_global_load_lds((const unsigned*)((const char*)(gbase) + (voff)[_i]), (PG8_LAS unsigned*)(lds + (bufoff) + ldsw + _i * 8192), 16, 0, 0); } while (0)
#define PG8_LDA(dst, b, h) do { _Pragma("unroll") for (int m = 0; m < 4; ++m) _Pragma("unroll") for (int k = 0; k < 2; ++k) dst[m][k] = *(const PG8_LAS bf16x8*)(lds + PG8_SA(b, h) + aoff + m * 2048 + k * 1024); } while (0)
#define PG8_LDB(dst, b, h) do { _Pragma("unroll") for (int n = 0; n < 2; ++n) _Pragma("unroll") for (int k = 0; k < 2; ++k) dst[n][k] = *(const PG8_LAS bf16x8*)(lds + PG8_SB(b, h) + boff + n * 2048 + k * 1024); } while (0)
#define PG8_MMA(ai, bj, At, Bt) do { __builtin_amdgcn_s_setprio(1); _Pragma("unroll") for (int m = 0; m < 4; ++m) _Pragma("unroll") for (int n = 0; n < 2; ++n) _Pragma("unroll") for (int k = 0; k < 2; ++k) \
        acc[ai][bj][m][n] = __builtin_amdgcn_mfma_f32_16x16x32_bf16(Bt[n][k], At[m][k], acc[ai][bj][m][n], 0, 0, 0); __builtin_amdgcn_s_setprio(0); } while (0)
#define PG8_WAIT_V(n) asm volatile("s_waitcnt vmcnt(" #n ")" ::: "memory")
#define PG8_WAIT_L(n) asm volatile("s_waitcnt lgkmcnt(" #n ")" ::: "memory")
#define PG8_BAR __builtin_amdgcn_s_barrier()
#define PG8_SCHED __builtin_amdgcn_sched_barrier(0)
    Unit cur, nxt; int ui = 0;
    if (!S.next(0, cur)) return;
    f32x4 acc[2][2][4][2];
#pragma unroll
    for (int a = 0; a < 2; ++a)
#pragma unroll
        for (int b = 0; b < 2; ++b)
#pragma unroll
            for (int m = 0; m < 4; ++m)
#pragma unroll
                for (int n = 0; n < 2; ++n) acc[a][b][m][n] = (f32x4){0.f, 0.f, 0.f, 0.f};
    bf16x8 At[4][2], B0[2][2], B1[2][2];
    const char* cA = (const char*)g.A + (size_t)cur.pm * tstep; const char* cB = (const char*)g.Bt + (size_t)cur.pn * tstep;
    S.a_ready(cur);
    if constexpr (SP2) {
        PG8_STAGE(PG8_SB(0, 0), cB, voffB); PG8_STAGE(PG8_SB(0, 1), cB + hstep, voffB); PG8_STAGE(PG8_SA(0, 0), cA, voffA); PG8_STAGE(PG8_SA(0, 1), cA + hstep, voffA);
        if (wr == 1) PG8_BAR;
        PG8_WAIT_V(2); PG8_BAR;
        PG8_STAGE(PG8_SB(1, 0), cB + kstep, voffB); PG8_STAGE(PG8_SA(1, 0), cA + kstep, voffA); PG8_STAGE(PG8_SB(1, 1), cB + hstep + kstep, voffB);
        PG8_WAIT_V(6); PG8_BAR;
    } else {
        PG8_STAGE(PG8_SB(0, 0), cB, voffB); PG8_STAGE(PG8_SA(0, 0), cA, voffA); PG8_STAGE(PG8_SB(0, 1), cB + hstep, voffB); PG8_STAGE(PG8_SA(0, 1), cA + hstep, voffA);
        if (wr == 1) PG8_BAR;
        PG8_WAIT_V(4); PG8_BAR;
        PG8_STAGE(PG8_SB(1, 0), cB + kstep, voffB); PG8_STAGE(PG8_SA(1, 0), cA + kstep, voffA); PG8_STAGE(PG8_SB(1, 1), cB + hstep + kstep, voffB);
        PG8_WAIT_V(6); PG8_BAR;
    }
    for (;;) {
        const bool has_next = S.next(ui + 1, nxt);
        const char* nA = has_next ? (const char*)g.A + (size_t)nxt.pm * tstep : cA; const char* nB = has_next ? (const char*)g.Bt + (size_t)nxt.pn * tstep : cB;
        for (int t = 0; t < nt; t += 2) {
            const bool last = (t == nt - 2);
            const char* a1 = cA + (size_t)(t + 1) * kstep;
            const char* a2 = last ? nA : cA + (size_t)(t + 2) * kstep; const char* b2 = last ? nB : cB + (size_t)(t + 2) * kstep;
            const char* a3 = a2 + kstep; const char* b3 = b2 + kstep;
            if (last && has_next) S.a_ready(nxt);
            if constexpr (SP2) {
            PG8_LDB(B0, 0, 0); PG8_LDB(B1, 0, 1); PG8_SCHED; PG8_LDA(At, 0, 0); PG8_STAGE(PG8_SA(1, 1), a1 + hstep, voffA);
            PG8_WAIT_V(8); PG8_WAIT_L(0); PG8_BAR; PG8_MMA(0, 0, At, B0); PG8_MMA(0, 1, At, B1); PG8_BAR; PG8_SCHED;
            PG8_LDA(At, 0, 1); PG8_STAGE(PG8_SB(0, 0), b2, voffB); PG8_STAGE(PG8_SB(0, 1), b2 + hstep, voffB); PG8_STAGE(PG8_SA(0, 0), a2, voffA);
            PG8_WAIT_V(8); PG8_WAIT_L(0); PG8_BAR; PG8_MMA(1, 0, At, B0); PG8_MMA(1, 1, At, B1); PG8_BAR; PG8_SCHED;
            PG8_LDB(B0, 1, 0); PG8_LDB(B1, 1, 1); PG8_SCHED; PG8_LDA(At, 1, 0); PG8_STAGE(PG8_SA(0, 1), a2 + hstep, voffA);
            PG8_WAIT_V(8); PG8_WAIT_L(0); PG8_BAR; PG8_MMA(0, 0, At, B0); PG8_MMA(0, 1, At, B1); PG8_BAR; PG8_SCHED;
            PG8_LDA(At, 1, 1); PG8_STAGE(PG8_SB(1, 0), b3, voffB); PG8_STAGE(PG8_SB(1, 1), b3 + hstep, voffB); PG8_STAGE(PG8_SA(1, 0), a3, voffA);
            PG8_WAIT_V(8); PG8_WAIT_L(0); PG8_BAR; PG8_MMA(1, 0, At, B0); PG8_MMA(1, 1, At, B1); PG8_BAR; PG8_SCHED;
            } else {
            PG8_LDB(B0, 0, 0); PG8_SCHED; PG8_LDA(At, 0, 0); PG8_STAGE(PG8_SA(1, 1), a1 + hstep, voffA);
            PG8_WAIT_L(8); PG8_BAR; PG8_WAIT_L(0); PG8_MMA(0, 0, At, B0); PG8_BAR; PG8_SCHED;
            PG8_LDB(B1, 0, 1); PG8_STAGE(PG8_SB(0, 0), b2, voffB);
            PG8_BAR; PG8_WAIT_L(0); PG8_MMA(0, 1, At, B1); PG8_BAR;
            PG8_LDA(At, 0, 1); PG8_STAGE(PG8_SA(0, 0), a2, voffA);
            PG8_BAR; PG8_WAIT_L(0); PG8_MMA(1, 0, At, B0); PG8_BAR; PG8_SCHED;
            PG8_STAGE(PG8_SB(0, 1), b2 + hstep, voffB);
            PG8_WAIT_V(6); PG8_BAR; PG8_MMA(1, 1, At, B1); PG8_BAR;
            PG8_LDB(B0, 1, 0); PG8_SCHED; PG8_LDA(At, 1, 0); PG8_STAGE(PG8_SA(0, 1), a2 + hstep, voffA);
            PG8_WAIT_L(8); PG8_BAR; PG8_WAIT_L(0); PG8_MMA(0, 0, At, B0); PG8_BAR; PG8_SCHED;
            PG8_LDB(B1, 1, 1); PG8_STAGE(PG8_SB(1, 0), b3, voffB);
            PG8_BAR; PG8_WAIT_L(0); PG8_MMA(0, 1, At, B1); PG8_BAR;
            PG8_LDA(At, 1, 1); PG8_STAGE(PG8_SA(1, 0), a3, voffA);
            PG8_BAR; PG8_WAIT_L(0); PG8_MMA(1, 0, At, B0); PG8_BAR; PG8_SCHED;
            PG8_STAGE(PG8_SB(1, 1), b3 + hstep, voffB);
            PG8_WAIT_V(6); PG8_BAR; PG8_MMA(1, 1, At, B1); PG8_BAR;
            }
        }
        if constexpr (ALIGN_EPI) { if (wr == 0) PG8_BAR; }
        if constexpr (!Epi::AFTER_DRAIN) { E(acc, cur, wr, wc, fr, fq); S.done(cur); }
        if (!has_next) break;
#pragma unroll
        for (int a = 0; a < 2; ++a)
#pragma unroll
            for (int b = 0; b < 2; ++b)
#pragma unroll
                for (int m = 0; m < 4; ++m)
#pragma unroll
                    for (int n = 0; n < 2; ++n) acc[a][b][m][n] = (f32x4){0.f, 0.f, 0.f, 0.f};
        cur = nxt; cA = nA; cB = nB; ++ui;
        if constexpr (ALIGN_EPI) { if (wr == 1) PG8_BAR; }
    }
    PG8_WAIT_V(0);
    if constexpr (!ALIGN_EPI) { if (wr == 0) PG8_BAR; }
    PG8_BAR;
    if constexpr (Epi::AFTER_DRAIN) { E.fused(acc, cur, wr, wc, fr, fq, lds, wid, lane); S.done(cur); }
#undef PG8_SA
#undef PG8_SB
#undef PG8_STAGE
#undef PG8_LDA
#undef PG8_LDB
#undef PG8_MMA
#undef PG8_WAIT_V
#undef PG8_WAIT_L
#undef PG8_BAR
#undef PG8_SCHED
}
}

constexpr int NB = 8, SEQ = 2048, CTXL = 256, TB = SEQ + CTXL  , MROWS = NB * TB  , DM = 2048;
constexpr float NORM_EPS = 1e-6f;
constexpr int NWAVES = 8;
constexpr int LDS_BYTES = 155648;
constexpr size_t MiB = 1u << 20;
constexpr size_t OFF_ADA = 0;
constexpr size_t OFF_BAR = 960 * 1024;
constexpr size_t OFF_WIN0 = 1 * MiB;
constexpr size_t OFF_WIN1 = OFF_WIN0 + 32 * MiB;
constexpr size_t OFF_WIN2 = OFF_WIN1 + 20 * MiB;
constexpr size_t OFF_WIN3 = OFF_WIN2 + 13 * MiB;
constexpr size_t OFF_WOUT = OFF_WIN3 + 32 * MiB;
constexpr size_t OFF_WQB = OFF_WOUT + 32 * MiB;
constexpr size_t OFF_WKVB = OFF_WQB + 3 * MiB;
constexpr size_t OFF_HCTX = OFF_WKVB + 4 * MiB;
constexpr size_t OFF_KR = OFF_HCTX + 16 * MiB;
constexpr size_t OFF_XN = OFF_KR + 3 * MiB;
constexpr size_t OFF_Q = OFF_XN + 72 * MiB;
constexpr size_t OFF_K = OFF_Q + 108 * MiB;
constexpr size_t OFF_V = OFF_K + 72 * MiB;
constexpr size_t OFF_G = OFF_V + 72 * MiB;
constexpr size_t WS_END = OFF_G + 72 * MiB;
constexpr int ADA_SPLIT = 16;

#define GAS __attribute__((address_space(1)))
#define LAS __attribute__((address_space(3)))
typedef unsigned short bf16_t;
typedef unsigned v4u __attribute__((ext_vector_type(4)));
typedef unsigned v2u __attribute__((ext_vector_type(2)));
typedef float f32x4 __attribute__((ext_vector_type(4)));
#define LDS_WAIT() asm volatile("s_waitcnt lgkmcnt(0)" ::: "memory")
__device__ __forceinline__ unsigned f2bf(float f) { unsigned u = __builtin_bit_cast(unsigned, f); return (u + 0x7fffu + ((u >> 16) & 1u)) >> 16; }
__device__ __forceinline__ unsigned pk2(float lo, float hi) { return f2bf(lo) | (f2bf(hi) << 16); }
__device__ __forceinline__ float bflo(unsigned w) { return __builtin_bit_cast(float, w << 16); }
__device__ __forceinline__ float bfhi(unsigned w) { return __builtin_bit_cast(float, w & 0xffff0000u); }
__device__ __forceinline__ float bf1(bf16_t h) { return __builtin_bit_cast(float, (unsigned)h << 16); }
__device__ __forceinline__ float wave_sum(float v) {
#pragma unroll
    for (int o = 1; o < 64; o <<= 1) v += __shfl_xor(v, o);
    return v;
}
__device__ __forceinline__ float silu_f(float x) { return x / (1.f + __expf(-x)); }

enum { PH_PRO = 0, PH_ADA,
       PH_L0_ROW, PH_L0_GIN, PH_L0_ATT, PH_L0_GOUT,
       PH_L1_ROW, PH_L1_GIN, PH_L1_POST, PH_L1_ATT, PH_L1_GOUT,
       PH_L2_ROW, PH_L2_GIN, PH_L2_POST, PH_L2_GQ, PH_L2_GKV, PH_L2_ATT, PH_L2_GOUT,
       PH_L3_ROW, PH_L3_GIN, PH_L3_ATT, PH_L3_GOUT, PH_FIN, NPH };

struct EpiRoute {
    static constexpr bool PERM = true, AFTER_DRAIN = false;
    int ph; unsigned char* ws;
    __device__ __forceinline__ void operator()(const pg8::f32x4 (&acc)[2][2][4][2], const pg8::Unit& u, int wr, int wc, int fr, int fq) const {
        int ph_ = ph; asm volatile("" : "+s"(ph_));
        constexpr int BIG = 1 << 29;
        bf16_t* Qb = (bf16_t*)(ws + OFF_Q); bf16_t* Kb = (bf16_t*)(ws + OFF_K); bf16_t* Vb = (bf16_t*)(ws + OFF_V); bf16_t* Gb = (bf16_t*)(ws + OFF_G);
        int c1 = BIG, c2 = BIG, c3 = BIG, ld0 = 2048, ld1 = 2048, ld2 = 2048, ld3 = 2048, rope0 = 0, rope1 = 0, nvalid = BIG, mode = 0;
        bf16_t *d0 = Qb, *d1 = Qb, *d2 = Qb, *d3 = Qb;
        float qs0 = 1.f;
        if (ph_ == PH_L0_GIN || ph_ == PH_L3_GIN) { c1 = 2048; c2 = 4096; c3 = 6144; d1 = Kb; d2 = Vb; d3 = Gb; rope0 = rope1 = 1; qs0 = 0.125f * 1.4426950408889634f; }
        else if (ph_ == PH_L1_GIN) { c1 = 2048; c2 = 2560; c3 = 3072; d1 = Kb; ld1 = 512; d2 = Vb; ld2 = 512; d3 = Gb; }
        else if (ph_ == PH_L2_GIN) { d0 = Vb; ld0 = 1088; c1 = 1088; d1 = Gb; nvalid = 3136; }
        else if (ph_ == PH_L2_GQ) { ld0 = 3072; rope0 = 2; }
        else if (ph_ == PH_L2_GKV) { mode = 1; d0 = Kb; d1 = Vb; }
        const int tb = u.pm % 9; const bool lat = tb < 8;
        float invf[4];
#pragma unroll
        for (int e = 0; e < 4; ++e) invf[e] = __builtin_amdgcn_exp2f(-(float)(4 * fq + e) * (13.287712379549449f / 16.f));
#pragma unroll
        for (int bj = 0; bj < 2; ++bj) {
            const int c0 = u.pn * 256 + bj * 128 + wc * 32;
            if (c0 >= nvalid) continue;
            bf16_t* dst; int ld, cl, rope; float scl = 1.f;
            if (mode == 1) { dst = bj ? d1 : d0; ld = 2048; cl = u.pn * 128 + wc * 32; rope = 0; }
            else if (c0 >= c3) { dst = d3; ld = ld3; cl = c0 - c3; rope = 0; }
            else if (c0 >= c2) { dst = d2; ld = ld2; cl = c0 - c2; rope = 0; }
            else if (c0 >= c1) { dst = d1; ld = ld1; cl = c0 - c1; rope = rope1; }
            else { dst = d0; ld = ld0; cl = c0; rope = rope0; scl = qs0; }
            const bool rp = lat && (rope == 1 || (rope == 2 && (c0 % 192) >= 128));
            const int par = (c0 >> 5) & 1;
            dst += cl + 8 * fq;
#pragma unroll
            for (int ai = 0; ai < 2; ++ai)
#pragma unroll
                for (int m = 0; m < 4; ++m) {
                    const size_t row = (size_t)u.pm * 256 + ai * 128 + wr * 64 + m * 16 + fr;
                    pg8::f32x4 v0 = acc[ai][bj][m][0] * scl, v1 = acc[ai][bj][m][1] * scl;
                    if (rp) {
                        const float pos = par ? (float)(16 * m + fr) : (float)(tb * 4 + 2 * ai + wr);
#pragma unroll
                        for (int e = 0; e < 4; ++e) { const float ang = pos * invf[e]; const float sn = __sinf(ang), cs = __cosf(ang);
                            const float a = v0[e], b = v1[e]; v0[e] = a * cs - b * sn; v1[e] = a * sn + b * cs; }
                    }
                    v4u w; w.x = pg8::cvt_pk_bf16(v0[0], v0[1]); w.y = pg8::cvt_pk_bf16(v0[2], v0[3]); w.z = pg8::cvt_pk_bf16(v1[0], v1[1]); w.w = pg8::cvt_pk_bf16(v1[2], v1[3]);
                    *(v4u*)(dst + row * ld) = w;
                }
        }
    }
};

#ifndef ATT_ASYM
#define ATT_ASYM 0
#endif
namespace att {
using bf16x8 = __attribute__((ext_vector_type(8))) short;
using s16x4  = __attribute__((ext_vector_type(4))) short;
using f32x16 = __attribute__((ext_vector_type(16))) float;
using u32x4  = __attribute__((ext_vector_type(4))) unsigned;
constexpr int NW = 8, QBLK = 32, KVBLK = 64;
constexpr float THR = 8.f;
constexpr int SHM_V = KVBLK * 128 * 2;
#define SBAR() __builtin_amdgcn_sched_barrier(0)
__device__ __forceinline__ int crow(int r, int hi) { return (r & 3) + 8 * (r >> 2) + 4 * hi; }
__device__ __forceinline__ unsigned cvtpk(float lo, float hi) { unsigned r; asm volatile("v_cvt_pk_bf16_f32 %0, %1, %2" : "=v"(r) : "v"(lo), "v"(hi)); return r; }
template <int DQK> struct Sc { static constexpr float SCALE = DQK == 64 ? 0.125f : (DQK == 128 ? 0.088388347648318440f : 0.072168783648703220f); };
template <int KW> __device__ __forceinline__ int kswz(int row, int colB) { return row * (KW * 2) + (colB ^ ((row & 7) << 4)); }

template <int DQK> __device__ __forceinline__ void partialSM(f32x16& p0, f32x16& p1, float& m_reg, float& mn, float& alpha) {
  constexpr float SCALE = Sc<DQK>::SCALE; constexpr float C = SCALE * 1.4426950408889634f;
  float pmax = p0[0];
#pragma unroll
  for (int r = 1; r < 16; ++r) pmax = fmaxf(pmax, p0[r]);
#pragma unroll
  for (int r = 0; r < 16; ++r) pmax = fmaxf(pmax, p1[r]);
  { auto rr = __builtin_amdgcn_permlane32_swap(__float_as_uint(pmax), __float_as_uint(pmax), false, false);
    pmax = fmaxf(__uint_as_float(rr[0]), __uint_as_float(rr[1])); }
  if (__builtin_expect(__all(pmax - m_reg <= THR / SCALE), 1)) { mn = m_reg; alpha = 1.f; }
  else { mn = fmaxf(m_reg, pmax); alpha = __builtin_amdgcn_exp2f((m_reg - mn) * C); m_reg = mn; }
  float mnC = -mn * C;
#pragma unroll
  for (int r = 0; r < 16; ++r) p0[r] = fmaf(p0[r], C, mnC);
#pragma unroll
  for (int r = 0; r < 16; ++r) p1[r] = fmaf(p1[r], C, mnC);
#pragma unroll
  for (int r = 0; r < 16; ++r) p0[r] = __builtin_amdgcn_exp2f(p0[r]);
}
constexpr float THRL = THR * 1.4426950408889634f;
template <bool FIRST> __device__ __forceinline__ void partialSM_ps(f32x16& p0, f32x16& p1, float& m_reg, float& alpha, f32x16& negm) {
  float pmax = p0[0];
#pragma unroll
  for (int r = 1; r < 16; ++r) pmax = fmaxf(pmax, p0[r]);
#pragma unroll
  for (int r = 0; r < 16; ++r) pmax = fmaxf(pmax, p1[r]);
  { auto rr = __builtin_amdgcn_permlane32_swap(__float_as_uint(pmax), __float_as_uint(pmax), false, false);
    pmax = fmaxf(__uint_as_float(rr[0]), __uint_as_float(rr[1])); }
  alpha = 1.f;
  if (FIRST || !__builtin_expect(__all(pmax <= THRL), 1)) {
    const float dl = FIRST ? pmax : fmaxf(pmax, 0.f); m_reg += dl;
#pragma unroll
    for (int r = 0; r < 16; ++r) { p0[r] -= dl; p1[r] -= dl; }
    if (!FIRST) alpha = __builtin_amdgcn_exp2f(-dl);
#pragma unroll
    for (int r = 0; r < 16; ++r) negm[r] = -m_reg;
    asm volatile("" : "+v"(negm));
  }
#pragma unroll
  for (int r = 0; r < 16; ++r) p0[r] = __builtin_amdgcn_exp2f(p0[r]);
}
__device__ __forceinline__ void finishSM(f32x16& p0, f32x16& p1, float alpha, float& l_reg, bf16x8& pa0, bf16x8& pa1, bf16x8& pa2, bf16x8& pa3) {
#pragma unroll
  for (int r = 0; r < 16; ++r) p1[r] = __builtin_amdgcn_exp2f(p1[r]);
  float ps = 0;
#pragma unroll
  for (int r = 0; r < 16; ++r) ps += p0[r];
#pragma unroll
  for (int r = 0; r < 16; ++r) ps += p1[r];
  { auto rr = __builtin_amdgcn_permlane32_swap(__float_as_uint(ps), __float_as_uint(ps), false, false);
    ps = __uint_as_float(rr[0]) + __uint_as_float(rr[1]); }
  l_reg = l_reg * alpha + ps;
#define PK4(P, BASE, OUT) do { unsigned a0 = cvtpk(P[BASE + 0], P[BASE + 1]), a1 = cvtpk(P[BASE + 2], P[BASE + 3]);   \
    unsigned b0 = cvtpk(P[BASE + 4], P[BASE + 5]), b1 = cvtpk(P[BASE + 6], P[BASE + 7]);                              \
    auto r0 = __builtin_amdgcn_permlane32_swap(a0, b0, false, false); auto r1 = __builtin_amdgcn_permlane32_swap(a1, b1, false, false); \
    u32x4 w = {r0[0], r1[0], r0[1], r1[1]}; OUT = *reinterpret_cast<bf16x8*>(&w); } while (0)
  PK4(p0, 0, pa0); PK4(p0, 8, pa1); PK4(p1, 0, pa2); PK4(p1, 8, pa3);
#undef PK4
}
template <int DQK, int KW, int QSP> __device__ __forceinline__ void qkt(f32x16& p0, f32x16& p1, const char* Ks, const int (&kb)[4], const bf16x8* qr, const char* qsp, const f32x16& cinit) {
  p0 = cinit; p1 = cinit;
  constexpr int N = DQK / 16;
#define KRD(d, lo) (*reinterpret_cast<const bf16x8*>(Ks + kb[(d) & 3] + ((d) >> 2) * 128 + ((lo) ? 0 : 32 * KW * 2)))
  bf16x8 f0[2], f1[2];
  f0[0] = KRD(0, 1); f1[0] = KRD(0, 0);
#pragma unroll
  for (int d0 = 0; d0 < N; ++d0) {
    if (d0 + 1 < N) { f0[(d0 + 1) & 1] = KRD(d0 + 1, 1); f1[(d0 + 1) & 1] = KRD(d0 + 1, 0); }
    __builtin_amdgcn_sched_barrier(0x406);
    bf16x8 qf;
    if constexpr (QSP > 0) { if (d0 >= N - QSP) qf = *reinterpret_cast<const bf16x8*>(qsp + (d0 - (N - QSP)) * 1024); else qf = qr[d0]; } else qf = qr[d0];
    p0 = __builtin_amdgcn_mfma_f32_32x32x16_bf16(f0[d0 & 1], qf, p0, 0, 0, 0);
    p1 = __builtin_amdgcn_mfma_f32_32x32x16_bf16(f1[d0 & 1], qf, p1, 0, 0, 0);
    __builtin_amdgcn_sched_barrier(0x406); }
#undef KRD
}
__device__ __forceinline__ int v_st(int k, int c) { const int kk = (k & ~0xC) | ((k & 4) << 1) | ((k & 8) >> 1); return ((kk >> 3) * 4 + (c >> 5)) * 512 + ((kk & 7) * 32 + (c & 31)) * 2; }
__device__ __forceinline__ int v_rd_base(int lane) { return ((lane & 3) << 3) | (((lane >> 2) & 3) << 6) | (((lane >> 4) & 1) << 5) | (((lane >> 5) & 1) << 8); }
constexpr int v_rd_off(int d0, int ks, int half) { return d0 * 512 + ks * 4096 + half * 2048; }
template <int OFF> __device__ __forceinline__ s16x4 tr_read(int vb) {
  s16x4 r; asm volatile("ds_read_b64_tr_b16 %0, %1 offset:%2" : "=&v"(r) : "v"(vb), "i"(OFF) : "memory"); return r;
}
template <int D0> __device__ __forceinline__ void pv_one(f32x16& od, int vb, bf16x8 pa0, bf16x8 pa1, bf16x8 pa2, bf16x8 pa3) {
  const s16x4 l0 = tr_read<v_rd_off(D0, 0, 0)>(vb), h0 = tr_read<v_rd_off(D0, 0, 1)>(vb), l1 = tr_read<v_rd_off(D0, 1, 0)>(vb), h1 = tr_read<v_rd_off(D0, 1, 1)>(vb);
  const s16x4 l2 = tr_read<v_rd_off(D0, 2, 0)>(vb), h2 = tr_read<v_rd_off(D0, 2, 1)>(vb), l3 = tr_read<v_rd_off(D0, 3, 0)>(vb), h3 = tr_read<v_rd_off(D0, 3, 1)>(vb);
  asm volatile("s_waitcnt lgkmcnt(0)" ::: "memory"); SBAR();
#define PK(L, H) (bf16x8){L[0], L[1], L[2], L[3], H[0], H[1], H[2], H[3]}
  od = __builtin_amdgcn_mfma_f32_32x32x16_bf16(pa0, PK(l0, h0), od, 0, 0, 0);
  od = __builtin_amdgcn_mfma_f32_32x32x16_bf16(pa1, PK(l1, h1), od, 0, 0, 0);
  od = __builtin_amdgcn_mfma_f32_32x32x16_bf16(pa2, PK(l2, h2), od, 0, 0, 0);
  od = __builtin_amdgcn_mfma_f32_32x32x16_bf16(pa3, PK(l3, h3), od, 0, 0, 0);
#undef PK
}
__device__ __forceinline__ void pv_d0(f32x16* o, int vb, bf16x8 pa0, bf16x8 pa1, bf16x8 pa2, bf16x8 pa3) {
  pv_one<0>(o[0], vb, pa0, pa1, pa2, pa3); pv_one<1>(o[1], vb, pa0, pa1, pa2, pa3); pv_one<2>(o[2], vb, pa0, pa1, pa2, pa3); pv_one<3>(o[3], vb, pa0, pa1, pa2, pa3);
}
struct VF { s16x4 l0, h0, l1, h1, l2, h2, l3, h3; };
template <int D0> __device__ __forceinline__ void vf_read(VF& f, int vb) {
  f.l0 = tr_read<v_rd_off(D0, 0, 0)>(vb); f.h0 = tr_read<v_rd_off(D0, 0, 1)>(vb); f.l1 = tr_read<v_rd_off(D0, 1, 0)>(vb); f.h1 = tr_read<v_rd_off(D0, 1, 1)>(vb);
  f.l2 = tr_read<v_rd_off(D0, 2, 0)>(vb); f.h2 = tr_read<v_rd_off(D0, 2, 1)>(vb); f.l3 = tr_read<v_rd_off(D0, 3, 0)>(vb); f.h3 = tr_read<v_rd_off(D0, 3, 1)>(vb);
}
__device__ __forceinline__ void vf_mma(f32x16& od, const VF& f, bf16x8 pa0, bf16x8 pa1, bf16x8 pa2, bf16x8 pa3) {
#define PK(L, H) (bf16x8){L[0], L[1], L[2], L[3], H[0], H[1], H[2], H[3]}
  od = __builtin_amdgcn_mfma_f32_32x32x16_bf16(pa0, PK(f.l0, f.h0), od, 0, 0, 0);
  od = __builtin_amdgcn_mfma_f32_32x32x16_bf16(pa1, PK(f.l1, f.h1), od, 0, 0, 0);
  od = __builtin_amdgcn_mfma_f32_32x32x16_bf16(pa2, PK(f.l2, f.h2), od, 0, 0, 0);
  od = __builtin_amdgcn_mfma_f32_32x32x16_bf16(pa3, PK(f.l3, f.h3), od, 0, 0, 0);
#undef PK
}
__device__ __forceinline__ void pv_d0_pipe(f32x16* o, int vb, bf16x8 pa0, bf16x8 pa1, bf16x8 pa2, bf16x8 pa3) {
  VF fa, fb;
  SBAR(); vf_read<0>(fa, vb); vf_read<1>(fb, vb);
  asm volatile("s_waitcnt lgkmcnt(8)" ::: "memory"); SBAR(); vf_mma(o[0], fa, pa0, pa1, pa2, pa3); SBAR();
  vf_read<2>(fa, vb); asm volatile("s_waitcnt lgkmcnt(8)" ::: "memory"); SBAR(); vf_mma(o[1], fb, pa0, pa1, pa2, pa3); SBAR();
  vf_read<3>(fb, vb); asm volatile("s_waitcnt lgkmcnt(8)" ::: "memory"); SBAR(); vf_mma(o[2], fa, pa0, pa1, pa2, pa3); SBAR();
  asm volatile("s_waitcnt lgkmcnt(0)" ::: "memory"); SBAR(); vf_mma(o[3], fb, pa0, pa1, pa2, pa3);
}

struct UnitP {
  const bf16_t* Qw;  int ldq;
  const bf16_t* K0;  int ldk0;
  const bf16_t* K1;  int ldk1;
  const bf16_t* Vh;  int ldv;
  const bf16_t* Gw;
  bf16_t* Ow;
  int nt;
  float lam, osc;
  const float* subg;
};

template <int DQK, int KW, bool DIFF, int SDEPTH, int QSP, int NBUF>
__device__ __forceinline__ void attn_unit(const UnitP& P, char* lds) {
  constexpr int SHM_K = KVBLK * KW * 2, NKC = KW / 64;
  const int tid = otid(), wid = tid >> 6, lane = tid & 63, r32 = lane & 31, hi = lane >> 5;
  char* V_lds = lds; char* K_lds = lds + NBUF * SHM_V;
  float* ws = (float*)(lds + NBUF * (SHM_V + SHM_K)) + wid * 64; float* li_l = ws; float* al_l = ws + 32;
  float m_reg = DIFF ? 0.f : -1e30f, l_reg = 0; f32x16 o[4] = {}; f32x16 negm = {}; if constexpr (DIFF) asm volatile("" : "+v"(negm));    constexpr int NQR = DQK / 16 - QSP; bf16x8 qr[NQR > 0 ? NQR : 1];
  char* qsp = lds + NBUF * (SHM_V + SHM_K) + 2048 + wid * (QSP * 1024) + lane * 16;
  const int coffB = DIFF ? (wid >> 2) * 128 : 0;
  { const bf16_t* Qp = P.Qw + (long)r32 * P.ldq + hi * 8;
#pragma unroll
    for (int d0 = 0; d0 < NQR; ++d0) qr[d0] = *reinterpret_cast<const bf16x8*>(Qp + d0 * 16);
#pragma unroll
    for (int d0 = NQR; d0 < DQK / 16; ++d0) *reinterpret_cast<bf16x8*>(qsp + (d0 - NQR) * 1024) = *reinterpret_cast<const bf16x8*>(Qp + d0 * 16); }
  const int sr = tid >> 4, sc = (tid & 15) * 8, vst0 = v_st(sr, sc), vst1 = v_st(32 + sr, sc);
  const int vb0 = (int)(uintptr_t)V_lds + v_rd_base(lane);
  int kb[4];
#pragma unroll
  for (int q = 0; q < 4; ++q) kb[q] = coffB + kswz<KW>(r32, q * 32 + hi * 16);
  const unsigned voff = (unsigned)(sr * P.ldv + sc) * 2u, koff = (unsigned)(sr * P.ldk0 + sc) * 2u, koff2 = (unsigned)((tid >> 3) * P.ldk1 + (tid & 7) * 8) * 2u;
  const int kdst0 = kswz<KW>(sr, sc * 2), kdst2 = kswz<KW>(tid >> 3, 256 + (tid & 7) * 16);
  struct { bf16x8 vs0, vs1, ks0, ks1, ks2; } sr_[SDEPTH];
#define SLOAD(i, t) do { const char* vt_ = (const char*)P.Vh + (size_t)(t) * (KVBLK * 2) * P.ldv; const char* kt_ = (const char*)P.K0 + (size_t)(t) * (KVBLK * 2) * P.ldk0; \
    sr_[i].vs0 = *reinterpret_cast<const bf16x8*>(vt_ + voff); sr_[i].vs1 = *reinterpret_cast<const bf16x8*>(vt_ + (size_t)64 * P.ldv + voff); \
    sr_[i].ks0 = *reinterpret_cast<const bf16x8*>(kt_ + koff); sr_[i].ks1 = *reinterpret_cast<const bf16x8*>(kt_ + (size_t)64 * P.ldk0 + koff); \
    if constexpr (KW == 192) sr_[i].ks2 = *reinterpret_cast<const bf16x8*>((const char*)P.K1 + (size_t)(t) * (KVBLK * 2) * P.ldk1 + koff2); } while (0)
#define SWRITE(b, i) do { *(bf16x8*)(V_lds + (b) * SHM_V + vst0) = sr_[i].vs0; *(bf16x8*)(V_lds + (b) * SHM_V + vst1) = sr_[i].vs1; \
    *(bf16x8*)(K_lds + (b) * SHM_K + kdst0) = sr_[i].ks0; *(bf16x8*)(K_lds + (b) * SHM_K + kdst0 + 32 * KW * 2) = sr_[i].ks1; \
    if constexpr (KW == 192) *(bf16x8*)(K_lds + (b) * SHM_K + kdst2) = sr_[i].ks2; } while (0)
#define SWAIT() do { if constexpr (SDEPTH == 2) { if constexpr (NKC == 2) asm volatile("s_waitcnt vmcnt(4)" ::: "memory"); else asm volatile("s_waitcnt vmcnt(5)" ::: "memory"); } \
    else asm volatile("s_waitcnt vmcnt(0)" ::: "memory"); } while (0)
#define RESC(a) do { if (__any((a) < 1.f)) { if (hi == 0) al_l[r32] = (a); asm volatile("s_waitcnt lgkmcnt(0)" ::: "memory"); \
    _Pragma("unroll") for (int d = 0; d < 4; ++d) _Pragma("unroll") for (int r = 0; r < 16; ++r) o[d][r] *= al_l[crow(r, hi)]; } } while (0)
#define PVD0(...) do { pv_d0(__VA_ARGS__); } while (0)
#define PSM(X0, X1, MN, AL, FIRST) do { if constexpr (DIFF) partialSM_ps<FIRST>(X0, X1, m_reg, AL, negm); else partialSM<DQK>(X0, X1, m_reg, MN, AL); } while (0)
  f32x16 pA0, pA1, pB0, pB1; float mnA, mnB, alA, alB; bf16x8 pa0, pa1, pa2, pa3; const int NT = P.nt;
  if constexpr (NBUF == 3) {
#define VM0() asm volatile("s_waitcnt vmcnt(0)" ::: "memory")
#define WGBAR() asm volatile("s_waitcnt lgkmcnt(0)\n\ts_barrier" ::: "memory")
#define RSTEP(C0, C1, MNC, ALC, P0, P1, ALP, WR, LD, TNEXT2) do { \
      SBAR(); qkt<DQK, KW, QSP>(C0, C1, K_lds + rcur * SHM_K, kb, qr, qsp, negm); \
      finishSM(P0, P1, ALP, l_reg, pa0, pa1, pa2, pa3); SBAR(); \
      if (WR) { VM0(); SWRITE(rnext, 0); } if (LD) SLOAD(0, (TNEXT2)); SBAR(); \
      PVD0(o, vb0 + rprev * SHM_V, pa0, pa1, pa2, pa3); PSM(C0, C1, MNC, ALC, false); \
      WGBAR(); RESC(ALC); \
      rprev = rcur; rcur = rnext; rnext = (rnext == 2) ? 0 : rnext + 1; } while (0)
    int rprev = 0, rcur = 1, rnext = 2;
    SLOAD(0, 0); VM0(); SWRITE(0, 0); SLOAD(0, 1); WGBAR();
    qkt<DQK, KW, QSP>(pA0, pA1, K_lds, kb, qr, qsp, negm); PSM(pA0, pA1, mnA, alA, true);
    VM0(); SWRITE(1, 0); if (2 < NT) SLOAD(0, 2); WGBAR();
    for (int j = 1; j + 1 < NT; j += 2) {
      RSTEP(pB0, pB1, mnB, alB, pA0, pA1, alA, true, true, j + 2);
      RSTEP(pA0, pA1, mnA, alA, pB0, pB1, alB, true, (j + 3 < NT), j + 3);
    }
    RSTEP(pB0, pB1, mnB, alB, pA0, pA1, alA, false, false, 0);
    finishSM(pB0, pB1, alB, l_reg, pa0, pa1, pa2, pa3); SBAR();
    PVD0(o, vb0 + rprev * SHM_V, pa0, pa1, pa2, pa3);
#undef RSTEP
#undef VM0
#undef WGBAR
  } else {
  constexpr int SE = 0, SO = SDEPTH - 1;
  SLOAD(SE, 0); asm volatile("s_waitcnt vmcnt(0)" ::: "memory"); SWRITE(0, SE); __syncthreads();
  qkt<DQK, KW, QSP>(pA0, pA1, K_lds, kb, qr, qsp, negm); PSM(pA0, pA1, mnA, alA, true);
  SLOAD(SO, 1); if constexpr (SDEPTH == 2) { if (2 < NT) SLOAD(SE, 2); }
  SWAIT(); SWRITE(1, SO); __syncthreads();
  if (ATT_ASYM == 0 || wid < 4) {
  for (int j = 1; j + 1 < NT; j += 2) {
    SBAR(); qkt<DQK, KW, QSP>(pB0, pB1, K_lds + SHM_K, kb, qr, qsp, negm);
    finishSM(pA0, pA1, alA, l_reg, pa0, pa1, pa2, pa3); SBAR();
    SLOAD(SO, (j + SDEPTH)); SBAR();
    PVD0(o, vb0, pa0, pa1, pa2, pa3); PSM(pB0, pB1, mnB, alB, false);
    __syncthreads(); SWAIT(); SWRITE(0, SE);
    RESC(alB); __syncthreads();
    SBAR(); qkt<DQK, KW, QSP>(pA0, pA1, K_lds, kb, qr, qsp, negm);
    finishSM(pB0, pB1, alB, l_reg, pa0, pa1, pa2, pa3); SBAR();
    if (SDEPTH == 1 || j + 3 < NT) SLOAD(SE, (j + 1 + SDEPTH)); SBAR();
    PVD0(o, vb0 + SHM_V, pa0, pa1, pa2, pa3); PSM(pA0, pA1, mnA, alA, false);
    __syncthreads(); SWAIT(); SWRITE(1, SO);
    RESC(alA); __syncthreads();
  }
  } else {
  for (int j = 1; j + 1 < NT; j += 2) {
    SBAR(); finishSM(pA0, pA1, alA, l_reg, pa0, pa1, pa2, pa3); SBAR();
    qkt<DQK, KW, QSP>(pB0, pB1, K_lds + SHM_K, kb, qr, qsp, negm); SBAR();
    SLOAD(SO, (j + SDEPTH)); SBAR();
    PSM(pB0, pB1, mnB, alB, false); SBAR();
    PVD0(o, vb0, pa0, pa1, pa2, pa3);
    __syncthreads(); SWAIT(); SWRITE(0, SE);
    RESC(alB); __syncthreads();
    SBAR(); finishSM(pB0, pB1, alB, l_reg, pa0, pa1, pa2, pa3); SBAR();
    qkt<DQK, KW, QSP>(pA0, pA1, K_lds, kb, qr, qsp, negm); SBAR();
    if (SDEPTH == 1 || j + 3 < NT) SLOAD(SE, (j + 1 + SDEPTH)); SBAR();
    PSM(pA0, pA1, mnA, alA, false); SBAR();
    PVD0(o, vb0 + SHM_V, pa0, pa1, pa2, pa3);
    __syncthreads(); SWAIT(); SWRITE(1, SO);
    RESC(alA); __syncthreads();
  }
  }
  SBAR(); qkt<DQK, KW, QSP>(pB0, pB1, K_lds + SHM_K, kb, qr, qsp, negm);
  finishSM(pA0, pA1, alA, l_reg, pa0, pa1, pa2, pa3); SBAR();
  PVD0(o, vb0, pa0, pa1, pa2, pa3); PSM(pB0, pB1, mnB, alB, false);
  __syncthreads(); RESC(alB);
  finishSM(pB0, pB1, alB, l_reg, pa0, pa1, pa2, pa3); SBAR();
  PVD0(o, vb0 + SHM_V, pa0, pa1, pa2, pa3);
  }
  if (hi == 0) li_l[r32] = l_reg; asm volatile("s_waitcnt lgkmcnt(0)" ::: "memory");
  float rli[16];
#pragma unroll
  for (int r = 0; r < 16; ++r) rli[r] = __builtin_amdgcn_rcpf(li_l[crow(r, hi)]);
#pragma unroll
  for (int d0 = 0; d0 < 4; ++d0)
#pragma unroll
    for (int r = 0; r < 16; ++r) o[d0][r] *= rli[r];
  constexpr bool OUT_ALIAS = (QSP > 0) || (NBUF == 3);
  bf16_t* stg = (bf16_t*)(lds + (OUT_ALIAS ? 0 : NBUF * (SHM_V + SHM_K) + 2048)) + wid * 4096;
#define GATE_STORE() do { asm volatile("s_waitcnt lgkmcnt(0)" ::: "memory"); \
    _Pragma("unroll") for (int i_ = 0; i_ < 8; ++i_) { const int idx_ = i_ * 64 + lane, row_ = idx_ >> 4, ch_ = idx_ & 15; \
      const u32x4 ov_ = *(const u32x4*)(stg + row_ * 128 + ch_ * 8); const u32x4 gv_ = *(const u32x4*)(P.Gw + (long)row_ * 2048 + ch_ * 8); u32x4 w_; \
      _Pragma("unroll") for (int q_ = 0; q_ < 4; ++q_) w_[q_] = pk2(bflo(ov_[q_]) * silu_f(bflo(gv_[q_])), bfhi(ov_[q_]) * silu_f(bfhi(gv_[q_]))); \
      *(u32x4*)(P.Ow + (long)row_ * 2048 + ch_ * 8) = w_; } } while (0)
  if constexpr (!DIFF) {
    if constexpr (OUT_ALIAS) __syncthreads();
#pragma unroll
    for (int r = 0; r < 16; ++r) { const int ro = crow(r, hi) * 128 + r32;
#pragma unroll
      for (int d0 = 0; d0 < 4; ++d0) stg[ro + d0 * 32] = (bf16_t)f2bf(o[d0][r]); }
    GATE_STORE();
    __syncthreads();
  } else {
    __syncthreads();
    float* st = (float*)lds + (wid & 3) * 4096 + lane;
    if (wid >= 4) {
#pragma unroll
      for (int d0 = 0; d0 < 4; ++d0)
#pragma unroll
        for (int r = 0; r < 16; ++r) st[(d0 * 16 + r) * 64] = o[d0][r];
    }
    __syncthreads();
    if (wid < 4) {
      if constexpr (OUT_ALIAS) stg = (bf16_t*)(lds + 65536) + wid * 4096;
      float sg[4];
#pragma unroll
      for (int d0 = 0; d0 < 4; ++d0) sg[d0] = P.subg[d0 * 32 + r32] * P.osc;
#pragma unroll
      for (int r = 0; r < 16; ++r) { float ss = 0.f;
#pragma unroll
        for (int d0 = 0; d0 < 4; ++d0) { const float v = o[d0][r] - P.lam * st[(d0 * 16 + r) * 64]; o[d0][r] = v; ss += v * v; }
        ss += __shfl_xor(ss, 1); ss += __shfl_xor(ss, 2); ss += __shfl_xor(ss, 4); ss += __shfl_xor(ss, 8); ss += __shfl_xor(ss, 16);
        const float rstd = __builtin_amdgcn_rsqf(ss * (1.f / 128.f) + NORM_EPS); const int ro = crow(r, hi) * 128 + r32;
#pragma unroll
        for (int d0 = 0; d0 < 4; ++d0) stg[ro + d0 * 32] = (bf16_t)f2bf(o[d0][r] * rstd * sg[d0]); }
      GATE_STORE();
    }
    __syncthreads();
  }
#undef GATE_STORE
#undef PVD0
#undef PSM
#undef SLOAD
#undef SWRITE
#undef SWAIT
#undef RESC
}
#undef SBAR
}

struct KArgs { const float* in[44]; float* out; unsigned char* ws; int ph_lo, ph_hi; };

#define PICK4(l, a, b, c, d) ((l) == 0 ? (a) : (l) == 1 ? (b) : (l) == 2 ? (c) : (d))

__device__ __forceinline__ void p0_transpose_item(const float* W, int K, int N, bf16_t* WT, LAS float* scr, int item, int lane, int pmode = 0) {
    const int nblk = N / 32, kb = item / nblk, nb = item % nblk, k0 = 64 * kb, n0 = 32 * nb;
    const bool pg = (pmode == 1 && n0 < 4096) || (pmode == 2 && (n0 % 192) >= 128);
#pragma unroll 8
    for (int i = 0; i < 32; ++i) { const int kk = 2 * i + (lane >> 5); scr[kk * 33 + (lane & 31)] = W[(size_t)(k0 + kk) * N + n0 + (lane & 31)]; }
    LDS_WAIT(); asm volatile("" ::: "memory");
    const int c = lane & 7;
#pragma unroll
    for (int j = 0; j < 4; ++j) { const int n = (lane >> 3) + 8 * j; const LAS float* s = scr + (8 * c) * 33 + n;
        v4u o; o.x = pk2(s[0 * 33], s[1 * 33]); o.y = pk2(s[2 * 33], s[3 * 33]); o.z = pk2(s[4 * 33], s[5 * 33]); o.w = pk2(s[6 * 33], s[7 * 33]);
        const int nr = pg ? (8 * ((n >> 2) & 3) + 4 * (n >> 4) + (n & 3)) : n;
        *(GAS v4u*)(WT + (size_t)(n0 + nr) * K + k0 + 8 * c) = o; }
    LDS_WAIT(); asm volatile("" ::: "memory");
}

__device__ __forceinline__ void phase_prologue(const KArgs& A, LAS unsigned char* lds, int wave, int lane) {
    LAS float* sl = (LAS float*)lds;
    for (int i = otid(); i < 9 * 2048; i += 512) { const int v = i >> 11, k = i & 2047; const float x = v < 8 ? A.in[1][v * 2048 + k] : A.in[3][k]; sl[i] = silu_f(x); }
    __syncthreads();
    const int gw = blockIdx.x * NWAVES + wave, NGW = gridDim.x * NWAVES;
    float* part = (float*)(A.ws + OFF_G);
    for (int task = gw; task < 4 * 24 * ADA_SPLIT; task += NGW) {
        const int l = task / (24 * ADA_SPLIT), rem = task % (24 * ADA_SPLIT), cgp = rem / ADA_SPLIT, s = rem % ADA_SPLIT;
        constexpr int KS = 2048 / ADA_SPLIT;
        const float* W = PICK4(l, A.in[4], A.in[15], A.in[23], A.in[33]) + (size_t)(s * KS) * 6144 + cgp * 256 + lane * 4;
        f32x4 acc[9];
#pragma unroll
        for (int v = 0; v < 9; ++v) acc[v] = (f32x4){0.f, 0.f, 0.f, 0.f};
        for (int k0 = 0; k0 < KS; k0 += 8) {
            f32x4 w[8];
#pragma unroll
            for (int i = 0; i < 8; ++i) w[i] = *(const f32x4*)(W + (size_t)(k0 + i) * 6144);
#pragma unroll
            for (int i = 0; i < 8; ++i)
#pragma unroll
                for (int v = 0; v < 9; ++v) acc[v] += w[i] * sl[v * 2048 + s * KS + k0 + i];
        }
#pragma unroll
        for (int v = 0; v < 9; ++v) *(f32x4*)(part + ((size_t)(s * 4 + l) * 9 + v) * 6144 + cgp * 256 + lane * 4) = acc[v];
    }
    LAS float* scr = (LAS float*)(lds + 73728 + wave * 8448);
    constexpr int I0 = 32 * 256, I1 = 32 * 160, I2 = 32 * 98, IO = 32 * 64, IQ = 8 * 96, IKV = 8 * 128;
    constexpr int NITEMS = 2 * I0 + I1 + I2 + 4 * IO + IQ + IKV;
    for (int it = gw; it < NITEMS; it += NGW) {
        int r = it;
        if (r < I0) { p0_transpose_item(A.in[8], 2048, 8192, (bf16_t*)(A.ws + OFF_WIN0), scr, r, lane, 1); continue; } r -= I0;
        if (r < I0) { p0_transpose_item(A.in[37], 2048, 8192, (bf16_t*)(A.ws + OFF_WIN3), scr, r, lane, 1); continue; } r -= I0;
        if (r < I1) { p0_transpose_item(A.in[19], 2048, 5120, (bf16_t*)(A.ws + OFF_WIN1), scr, r, lane); continue; } r -= I1;
        if (r < I2) { p0_transpose_item(A.in[27], 2048, 3136, (bf16_t*)(A.ws + OFF_WIN2), scr, r, lane); continue; } r -= I2;
        if (r < 4 * IO) { const int l = r / IO; p0_transpose_item(PICK4(l, A.in[14], A.in[22], A.in[32], A.in[43]), 2048, 2048, (bf16_t*)(A.ws + OFF_WOUT) + (size_t)l * 2048 * 2048, scr, r % IO, lane); continue; } r -= 4 * IO;
        if (r < IQ) { p0_transpose_item(A.in[29], 512, 3072, (bf16_t*)(A.ws + OFF_WQB), scr, r, lane, 2); continue; } r -= IQ;
        p0_transpose_item(A.in[31], 512, 4096, (bf16_t*)(A.ws + OFF_WKVB), scr, r, lane);
    }
    { v4u* z = (v4u*)((bf16_t*)(A.ws + OFF_WIN2) + (size_t)3136 * 2048); const int n16 = 192 * 2048 * 2 / 16;
      unsigned zz = 0u; asm volatile("" : "+v"(zz));
      for (int i = blockIdx.x * 512 + otid(); i < n16; i += gridDim.x * 512) z[i] = (v4u){zz, zz, zz, zz}; }
}

__device__ __forceinline__ void phase_ada_reduce(const KArgs& A) {
    const float* part = (const float*)(A.ws + OFF_G); float* ada = (float*)(A.ws + OFF_ADA);
    constexpr int NTOT = 4 * 9 * 6144;
    for (int i = blockIdx.x * 512 + otid(); i < NTOT; i += gridDim.x * 512) {
        const int l = i / (9 * 6144), c = i % 6144;
        float s = PICK4(l, A.in[5], A.in[16], A.in[24], A.in[34])[c];
#pragma unroll
        for (int k = 0; k < ADA_SPLIT; ++k) s += part[(size_t)k * NTOT + i];
        ada[i] = s;
    }
}

__device__ __forceinline__ void phase_rowpass(const KArgs& A, int l, int wave, int lane, bool dummy = false) {
    const bool first = (l == 0), last = (l == 4);
    const int gw = blockIdx.x * NWAVES + wave, NGW = gridDim.x * NWAVES;
    const float* ada = (const float*)(A.ws + OFF_ADA);
    const int lp = l - 1;
    const float* post_g = first ? nullptr : PICK4(lp, A.in[7], A.in[18], A.in[26], A.in[36]);
    const float* pre_g = last ? nullptr : PICK4(l, A.in[6], A.in[17], A.in[25], A.in[35]);
    const bf16_t* Y = (const bf16_t*)(A.ws + OFF_Q); bf16_t* XN = (bf16_t*)(A.ws + (dummy ? OFF_G : OFF_XN)); float* hctx = (float*)(A.ws + OFF_HCTX);
    for (int r = gw; r < MROWS; r += NGW) {
        const int b = r / TB, t = r % TB; const bool lat = t < SEQ; const int v = lat ? b : 8;
        if (last && !lat) continue;
        const size_t hoff = lat ? ((size_t)b * SEQ + t) * DM : ((size_t)b * CTXL + (t - SEQ)) * DM;
        const float* hin = (l <= 1 ? (lat ? A.in[0] : A.in[2]) : (lat ? (const float*)A.out : (const float*)hctx)) + hoff;
        float* hout = dummy ? (float*)(A.ws + OFF_K) + (size_t)r * DM : (lat ? A.out : hctx) + hoff;
        f32x4 h[8];
#pragma unroll
        for (int j = 0; j < 8; ++j) h[j] = *(const f32x4*)(hin + 4 * lane + 256 * j);
        if (!first) {
            f32x4 y[8]; float ss = 0.f;
#pragma unroll
            for (int j = 0; j < 8; ++j) {
                if (lat || !GOUT_SPLIT) { const v2u w = *(const v2u*)(Y + (size_t)r * DM + 4 * lane + 256 * j); y[j] = (f32x4){bflo(w.x), bfhi(w.x), bflo(w.y), bfhi(w.y)}; }
                else { y[j] = (f32x4){0.f, 0.f, 0.f, 0.f};
#pragma unroll
                    for (int kq = 0; kq < 4; ++kq) { const v2u w = *(const v2u*)((const bf16_t*)(A.ws + OFF_V) + ((size_t)kq * 2048 + (size_t)b * CTXL + (t - SEQ)) * DM + 4 * lane + 256 * j);
                        y[j] += (f32x4){bflo(w.x), bfhi(w.x), bflo(w.y), bfhi(w.y)}; } }
                ss += (y[j].x * y[j].x + y[j].y * y[j].y) + (y[j].z * y[j].z + y[j].w * y[j].w); }
            const float rstd = 1.f / sqrtf(wave_sum(ss) * (1.f / DM) + NORM_EPS);
            const float* gate = ada + ((size_t)lp * 9 + v) * 6144 + 4096;
#pragma unroll
            for (int j = 0; j < 8; ++j) { const int c = 4 * lane + 256 * j; const f32x4 gt = *(const f32x4*)(gate + c), pg = *(const f32x4*)(post_g + c);
                h[j] += gt * (y[j] * rstd * pg); *(f32x4*)(hout + c) = h[j]; }
        }
        if (!last) {
            float ss = 0.f;
#pragma unroll
            for (int j = 0; j < 8; ++j) ss += (h[j].x * h[j].x + h[j].y * h[j].y) + (h[j].z * h[j].z + h[j].w * h[j].w);
            const float rstd = 1.f / sqrtf(wave_sum(ss) * (1.f / DM) + NORM_EPS);
            const float* shift = ada + ((size_t)l * 9 + v) * 6144; const float* scale = shift + 2048;
#pragma unroll
            for (int j = 0; j < 8; ++j) { const int c = 4 * lane + 256 * j; const f32x4 sh = *(const f32x4*)(shift + c), sc = *(const f32x4*)(scale + c), pg = *(const f32x4*)(pre_g + c);
                const f32x4 x = (h[j] * rstd * pg) * (sc + 1.f) + sh; v2u w; w.x = pk2(x.x, x.y); w.y = pk2(x.z, x.w);
                *(v2u*)(XN + (size_t)r * DM + c) = w; }
        }
    }
}

__device__ __forceinline__ void nr128(bf16_t* p, const float* g, bool lat, int t, int qd) {
    const int half = qd >> 1, jh = qd & 1, d0 = 64 * half + 16 * jh;
    v4u a0 = *(const v4u*)(p + d0), a1 = *(const v4u*)(p + d0 + 8), b0 = *(const v4u*)(p + d0 + 32), b1 = *(const v4u*)(p + d0 + 40);
    float xa[16], xb[16];
#pragma unroll
    for (int i = 0; i < 4; ++i) { xa[2 * i] = bflo(a0[i]); xa[2 * i + 1] = bfhi(a0[i]); xa[8 + 2 * i] = bflo(a1[i]); xa[8 + 2 * i + 1] = bfhi(a1[i]);
        xb[2 * i] = bflo(b0[i]); xb[2 * i + 1] = bfhi(b0[i]); xb[8 + 2 * i] = bflo(b1[i]); xb[8 + 2 * i + 1] = bfhi(b1[i]); }
    float ss = 0.f;
#pragma unroll
    for (int i = 0; i < 16; ++i) ss += xa[i] * xa[i] + xb[i] * xb[i];
    ss += __shfl_xor(ss, 1); ss += __shfl_xor(ss, 2);
    const float rstd = 1.f / sqrtf(ss * (1.f / 128.f) + NORM_EPS);
    const float pos = half ? (float)(t & 63) : (float)(t >> 6);
#pragma unroll
    for (int i = 0; i < 16; ++i) { float x1 = xa[i] * rstd * g[d0 + i], x2 = xb[i] * rstd * g[d0 + 32 + i];
        if (lat) { const float ang = pos * __builtin_amdgcn_exp2f(-(float)(16 * jh + i) * (13.287712379549449f / 32.f)); const float sn = __sinf(ang), cs = __cosf(ang);
            const float o1 = x1 * cs - x2 * sn, o2 = x1 * sn + x2 * cs; x1 = o1; x2 = o2; }
        xa[i] = x1; xb[i] = x2; }
#pragma unroll
    for (int i = 0; i < 4; ++i) { a0[i] = pk2(xa[2 * i], xa[2 * i + 1]); a1[i] = pk2(xa[8 + 2 * i], xa[8 + 2 * i + 1]); b0[i] = pk2(xb[2 * i], xb[2 * i + 1]); b1[i] = pk2(xb[8 + 2 * i], xb[8 + 2 * i + 1]); }
    *(v4u*)(p + d0) = a0; *(v4u*)(p + d0 + 8) = a1; *(v4u*)(p + d0 + 32) = b0; *(v4u*)(p + d0 + 40) = b1;
}
__device__ __forceinline__ void phase_post_gqa(const KArgs& A, int wave, int lane) {
    const int gw = blockIdx.x * NWAVES + wave, NGW = gridDim.x * NWAVES;
    bf16_t* Q = (bf16_t*)(A.ws + OFF_Q); bf16_t* K = (bf16_t*)(A.ws + OFF_K);
    for (int r = gw; r < MROWS; r += NGW) { const int t = r % TB; const bool lat = t < SEQ;
        nr128(Q + (size_t)r * 2048 + (lane >> 2) * 128, A.in[20], lat, t, lane & 3);
        if (lane < 16) nr128(K + (size_t)r * 512 + (lane >> 2) * 128, A.in[21], lat, t, lane & 3); }
}
__device__ __forceinline__ void phase_post_mla(const KArgs& A, int wave, int lane) {
    const int gw = blockIdx.x * NWAVES + wave, NGW = gridDim.x * NWAVES;
    const bf16_t* RAW = (const bf16_t*)(A.ws + OFF_V); bf16_t* NQA = (bf16_t*)(A.ws + OFF_XN); bf16_t* NKVA = NQA + (size_t)MROWS * 512; bf16_t* KR = (bf16_t*)(A.ws + OFF_KR);
    for (int r = gw; r < MROWS; r += NGW) { const int t = r % TB; const bool lat = t < SEQ; const bf16_t* row = RAW + (size_t)r * 1088;
#pragma unroll
        for (int part = 0; part < 2; ++part) {
            const v4u w = *(const v4u*)(row + part * 512 + 8 * lane); float x[8]; float ss = 0.f;
#pragma unroll
            for (int i = 0; i < 4; ++i) { x[2 * i] = bflo(w[i]); x[2 * i + 1] = bfhi(w[i]); ss += x[2 * i] * x[2 * i] + x[2 * i + 1] * x[2 * i + 1]; }
            const float rstd = 1.f / sqrtf(wave_sum(ss) * (1.f / 512.f) + NORM_EPS);
            const float* g = (part ? A.in[30] : A.in[28]) + 8 * lane; v4u o;
#pragma unroll
            for (int i = 0; i < 4; ++i) o[i] = pk2(x[2 * i] * rstd * g[2 * i], x[2 * i + 1] * rstd * g[2 * i + 1]);
            *(v4u*)((part ? NKVA : NQA) + (size_t)r * 512 + 8 * lane) = o;
        }
        if (lane < 32) { const int half = lane >> 4, j = lane & 15; float x1 = bf1(row[1024 + 32 * half + j]), x2 = bf1(row[1024 + 32 * half + 16 + j]);
            if (lat) { const float pos = half ? (float)(t & 63) : (float)(t >> 6); const float ang = pos * __builtin_amdgcn_exp2f(-(float)j * (13.287712379549449f / 16.f));
                const float sn = __sinf(ang), cs = __cosf(ang); const float o1 = x1 * cs - x2 * sn, o2 = x1 * sn + x2 * cs; x1 = o1; x2 = o2; }
            const int g1 = 8 * ((j >> 2) & 3) + (j & 3);
            KR[(size_t)r * 64 + 32 * half + g1] = (bf16_t)f2bf(x1); KR[(size_t)r * 64 + 32 * half + g1 + 4] = (bf16_t)f2bf(x2); }
    }
}

template <int DQK, int KW, bool DIFF, int SD, int QSP, int NBUF>
__device__ __forceinline__ void phase_attn(const KArgs& A, char* lds, int layer, bool need_ctx, int wave, int lane) {
    const bf16_t* Q = (const bf16_t*)(A.ws + OFF_Q); const bf16_t* K = (const bf16_t*)(A.ws + OFF_K); const bf16_t* V = (const bf16_t*)(A.ws + OFF_V);
    const bf16_t* G = (const bf16_t*)(A.ws + OFF_G); const bf16_t* KR = (const bf16_t*)(A.ws + OFF_KR); bf16_t* O = (bf16_t*)(A.ws + OFF_XN);
    float lam = 0.f, osc = 0.f; const float* subg = nullptr;
    if constexpr (DIFF) {
        const float* q1 = layer == 0 ? A.in[9] : A.in[38]; const float* k1 = layer == 0 ? A.in[10] : A.in[39];
        const float* q2 = layer == 0 ? A.in[11] : A.in[40]; const float* k2 = layer == 0 ? A.in[12] : A.in[41];
        const float linit = layer == 0 ? 0.2f : 0.55605820435704293f;
        lam = __expf(wave_sum(q1[lane] * k1[lane])) - __expf(wave_sum(q2[lane] * k2[lane])) + linit; osc = 1.f - linit;
        subg = layer == 0 ? A.in[13] : A.in[42];
    }
    constexpr int RPU = DIFF ? 128 : 256, UPB = SEQ / RPU, CPB = CTXL / RPU;
    const int nbig = NB * 16 * UPB, ntot = nbig + (need_ctx ? NB * 16 * CPB : 0);
    const int vcu = (gridDim.x % 8 == 0) ? (int)(blockIdx.x % 8) * (int)(gridDim.x / 8) + (int)(blockIdx.x / 8) : (int)blockIdx.x;
    for (int u = vcu; u < ntot; u += gridDim.x) {
        int bh, qrow, krow, nt;
        if (u < nbig) { bh = u / UPB; qrow = (u % UPB) * RPU; krow = 0; nt = TB / 64; }
        else { const int u2 = u - nbig; bh = u2 / CPB; qrow = SEQ + (u2 % CPB) * RPU; krow = SEQ; nt = CTXL / 64; }
        const int b = bh >> 4, h = bh & 15;
        const long r0 = (long)b * TB + qrow + (DIFF ? 32 * (wave & 3) : 32 * wave), k0 = (long)b * TB + krow;
        att::UnitP P;
        if constexpr (DIFF) { P.Qw = Q + r0 * 2048 + h * 128 + (wave >> 2) * 64; P.ldq = 2048; P.K0 = K + k0 * 2048 + h * 128; P.ldk0 = 2048; P.K1 = nullptr; P.ldk1 = 0; P.Vh = V + k0 * 2048 + h * 128; P.ldv = 2048; }
        else if constexpr (DQK == 128) { P.Qw = Q + r0 * 2048 + h * 128; P.ldq = 2048; P.K0 = K + k0 * 512 + (h >> 2) * 128; P.ldk0 = 512; P.K1 = nullptr; P.ldk1 = 0; P.Vh = V + k0 * 512 + (h >> 2) * 128; P.ldv = 512; }
        else { P.Qw = Q + r0 * 3072 + h * 192; P.ldq = 3072; P.K0 = K + k0 * 2048 + h * 128; P.ldk0 = 2048; P.K1 = KR + k0 * 64; P.ldk1 = 64; P.Vh = V + k0 * 2048 + h * 128; P.ldv = 2048; }
        P.Gw = G + r0 * 2048 + h * 128; P.Ow = O + r0 * 2048 + h * 128; P.nt = nt; P.lam = lam; P.osc = osc; P.subg = subg;
        att::attn_unit<DQK, KW, DIFF, SD, QSP, NBUF>(P, lds);
    }
}

#define XB_TMO      128
#define XB_XCNT(j)  (256  + 64 * (j))
#define XB_XSUB(j)  (1280 + 64 * (j))
#define XB_XGEN(j)  (2304 + 64 * (j))
#define XB_TOP      3328
#define XB_TOPGEN   3392
#define XCD_BAR_WORDS 3456
#define XB_SPIN_CAP (1u << 18)

__device__ __forceinline__ unsigned xb_ld(unsigned* p)              { return __hip_atomic_load(p, __ATOMIC_RELAXED, __HIP_MEMORY_SCOPE_AGENT); }
__device__ __forceinline__ unsigned xb_add(unsigned* p, unsigned v) { return __hip_atomic_fetch_add(p, v, __ATOMIC_RELAXED, __HIP_MEMORY_SCOPE_AGENT); }
__device__ __forceinline__ unsigned xb_xcc_id() { return (unsigned)__builtin_amdgcn_s_getreg((3 << 11) | 20) & 0xFu; }
#define XB_SPIN(cond, bar) do { unsigned _sp = 0; while (cond) { __builtin_amdgcn_s_sleep(1); \
    if ((++_sp & 255u) == 0u) { if (xb_ld(&(bar)[XB_TMO])) break; if (_sp > XB_SPIN_CAP) { atomicAdd(&(bar)[XB_TMO], 1u); break; } } } } while (0)

struct XcdBarrier {
    unsigned* bar; unsigned x;
    volatile LAS unsigned* st;
};

__device__ __forceinline__ XcdBarrier xcd_barrier_post(unsigned* bar, volatile LAS unsigned* st) {
    XcdBarrier b; b.bar = bar; b.x = xb_xcc_id(); b.st = st;
    if (threadIdx.x == 0) (void)xb_add(&bar[XB_XCNT(b.x)], 1u);
    return b;
}
__device__ __forceinline__ void xcd_barrier_complete(unsigned* bar, unsigned x, unsigned& nloc, unsigned& nx) {
    const unsigned G = gridDim.x * gridDim.y * gridDim.z;
    unsigned sum, cnt, mine, sp = 0u;
    for (;;) {
        sum = 0u; cnt = 0u; mine = 0u;
#pragma unroll
        for (unsigned j = 0; j < 16; ++j) { const unsigned c = xb_ld(&bar[XB_XCNT(j)]); sum += c; cnt += (c > 0u) ? 1u : 0u; mine = (j == x) ? c : mine; }
        if (sum == G) break;
        __builtin_amdgcn_s_sleep(1);
        if ((++sp & 255u) == 0u) { if (xb_ld(&bar[XB_TMO])) break; if (sp > XB_SPIN_CAP) { atomicAdd(&bar[XB_TMO], 1u); break; } }
    }
    nloc = mine > 0u ? mine : 1u; nx = cnt > 0u ? cnt : 1u;
}

__device__ __forceinline__ void xcd_barrier(const XcdBarrier& b) {
    asm volatile("s_waitcnt vmcnt(0)" ::: "memory");
    __syncthreads();
    if (threadIdx.x == 0) {
        unsigned* bar = b.bar;
        __builtin_amdgcn_s_waitcnt(0);
        unsigned nloc = b.st[0], nx = b.st[1];
        if (nloc == 0u) { xcd_barrier_complete(bar, b.x, nloc, nx); b.st[0] = nloc; b.st[1] = nx; }
        const unsigned old = xb_add(&bar[XB_XSUB(b.x)], 1u);
        const unsigned gen = old / nloc;
        if (old + 1u == (gen + 1u) * nloc) {
            __builtin_amdgcn_fence(__ATOMIC_RELEASE, "agent");
            asm volatile("s_waitcnt vmcnt(0)" ::: "memory");
            const unsigned og = xb_add(&bar[XB_TOP], 1u);
            const unsigned tg = og / nx;
            if (og + 1u == (tg + 1u) * nx) xb_add(&bar[XB_TOPGEN], 1u);
            else XB_SPIN(xb_ld(&bar[XB_TOPGEN]) == tg, bar);
            __builtin_amdgcn_fence(__ATOMIC_ACQUIRE, "agent");
            xb_add(&bar[XB_XGEN(b.x)], 1u);
            asm volatile("s_waitcnt vmcnt(0)" ::: "memory");
        } else {
            XB_SPIN(xb_ld(&bar[XB_XGEN(b.x)]) == gen, bar);
            __builtin_amdgcn_fence(__ATOMIC_ACQUIRE, "agent");
            asm volatile("s_waitcnt vmcnt(0)" ::: "memory");
        }
    }
    __syncthreads();
}

__global__ void __launch_bounds__(512) fwd_kernel(KArgs A0) {
    extern __shared__ __attribute__((aligned(16))) unsigned char lds[];
    cg::grid_group grid = cg::this_grid();
    LAS unsigned char* ldsl = (LAS unsigned char*)lds;
    volatile LAS unsigned* bst = (volatile LAS unsigned*)(ldsl + LDS_BYTES - 16);
    if (threadIdx.x < 4) bst[threadIdx.x] = 0u;
    __syncthreads();
    XcdBarrier xbar = xcd_barrier_post((unsigned*)(A0.ws + OFF_BAR), bst);
#ifndef REPMASK
#define REPMASK 0
#endif
    const int ph_lo = A0.ph_lo, ph_hi = A0.ph_hi;
    if (ph_lo < 0) grid.sync();
    for (int ph = ph_lo; ph < ph_hi; ++ph) {
      {
        const int tid_ = otid(); const int lane = tid_ & 63, wave = __builtin_amdgcn_readfirstlane(tid_ >> 6);
        const KArgs __attribute__((address_space(4)))* ap_ = (const KArgs __attribute__((address_space(4)))*)__builtin_amdgcn_kernarg_segment_ptr();
        asm volatile("" : "+s"(ap_));
        const KArgs& A = *(const KArgs*)ap_;
        unsigned char* ws = A.ws;
#ifndef PM
#define PM 0xff
#endif
#ifndef ATT_NBUF
#define ATT_NBUF 3
#endif
#define ATT_SD0 (ATT_NBUF == 3 ? 1 : ATT_SD)
#ifndef ATT_SD
#define ATT_SD 2
#endif
        if (ph == PH_PRO) { if (PM & 1) phase_prologue(A, ldsl, wave, lane); }
        else if (ph == PH_ADA) phase_ada_reduce(A);
        else if (ph == PH_L0_ROW || ph == PH_L1_ROW || ph == PH_L2_ROW || ph == PH_L3_ROW || ph == PH_FIN)
            { if (PM & 2) phase_rowpass(A, ph == PH_L0_ROW ? 0 : ph == PH_L1_ROW ? 1 : ph == PH_L2_ROW ? 2 : ph == PH_L3_ROW ? 3 : 4, wave, lane); }
        else if (ph == PH_L1_POST) { if (PM & 4) phase_post_gqa(A, wave, lane); }
        else if (ph == PH_L2_POST) { if (PM & 4) phase_post_mla(A, wave, lane); }
        else if (ph == PH_L0_ATT || ph == PH_L3_ATT) { if (PM & 8) phase_attn<64, 128, true, ATT_SD0, 0, ATT_NBUF>(A, (char*)lds, ph == PH_L0_ATT ? 0 : 3, ph == PH_L0_ATT, wave, lane); }
        else if (ph == PH_L1_ATT) { if (PM & 16) phase_attn<128, 128, false, ATT_SD0, 4, ATT_NBUF>(A, (char*)lds, 1, true, wave, lane); }
        else if (ph == PH_L2_ATT) { if (PM & 32) phase_attn<192, 192, false, 1, 3, ATT_NBUF>(A, (char*)lds, 2, true, wave, lane); }
        else if (PM & 64) {
            bf16_t* XN = (bf16_t*)(ws + OFF_XN);
            const bool is_gout = (ph == PH_L0_GOUT || ph == PH_L1_GOUT || ph == PH_L2_GOUT || ph == PH_L3_GOUT);
            pg8::Gemm g; EpiRoute E; E.ph = ph; E.ws = ws;
            g.A = XN; g.M = MROWS; g.K = 2048; g.ld = 2048;
            if (ph == PH_L0_GIN || ph == PH_L3_GIN) { g.Bt = (const bf16_t*)(ws + (ph == PH_L0_GIN ? OFF_WIN0 : OFF_WIN3)); g.N = 8192; }
            else if (ph == PH_L1_GIN) { g.Bt = (const bf16_t*)(ws + OFF_WIN1); g.N = 5120; }
            else if (ph == PH_L2_GIN) { g.Bt = (const bf16_t*)(ws + OFF_WIN2); g.N = 3328; }
            else if (ph == PH_L2_GQ) { g.K = 512; g.ld = 512; g.Bt = (const bf16_t*)(ws + OFF_WQB); g.N = 3072; }
            else if (ph == PH_L2_GKV) { g.A = XN + (size_t)MROWS * 512; g.K = 512; g.ld = 512; g.Bt = (const bf16_t*)(ws + OFF_WKVB); g.N = 4096; }
            else { const int l = ph == PH_L0_GOUT ? 0 : ph == PH_L1_GOUT ? 1 : ph == PH_L2_GOUT ? 2 : 3; g.Bt = (const bf16_t*)(ws + OFF_WOUT) + (size_t)l * 2048 * 2048; g.N = 2048; }
            pg8::StaticOrder S; S.init(g.M, g.N, (int)gridDim.x, (int)blockIdx.x);
            if (ph == PH_L3_GOUT) { S.init(NB * SEQ, g.N, (int)gridDim.x, (int)blockIdx.x); S.skip9 = true; }
            pg8::gemm_phase<EpiRoute, pg8::StaticOrder, true, true>(ldsl, g, S, E);
        }
      }
        if (ph + 1 < ph_hi && ph != PH_L2_GQ) { unsigned* bp_ = xbar.bar; asm volatile("" : "+s"(bp_)); XcdBarrier xb_ = xbar; xb_.bar = bp_; xcd_barrier(xb_); }
    }
}

#ifndef MK_ONE_LAUNCH
#define MK_ONE_LAUNCH 1
#endif
extern "C" void kernel_launch(void* const* d_in, const int* in_sizes, int n_in, void* d_out, int out_size, void* d_ws, size_t ws_size, hipStream_t stream) {
    static int grid = 0;
    if (grid == 0) {
        if (n_in != 44 || out_size != NB * SEQ * DM || ws_size < WS_END) { fprintf(stderr, "kernel_launch: unexpected shapes n_in %d out %d ws %zu (need %zu)\n", n_in, out_size, ws_size, (size_t)WS_END); grid = -1; return; }
        int dev = 0, cus = 0, per_cu = 0;
        hipGetDevice(&dev); hipDeviceGetAttribute(&cus, hipDeviceAttributeMultiprocessorCount, dev);
        if (hipFuncSetAttribute((const void*)fwd_kernel, hipFuncAttributeMaxDynamicSharedMemorySize, LDS_BYTES) != hipSuccess) { fprintf(stderr, "kernel_launch: hipFuncSetAttribute failed\n"); grid = -1; return; }
        if (hipOccupancyMaxActiveBlocksPerMultiprocessor(&per_cu, (const void*)fwd_kernel, 512, LDS_BYTES) != hipSuccess || per_cu < 1) { fprintf(stderr, "kernel_launch: occupancy query gave %d\n", per_cu); per_cu = 1; }
        (void)hipGetLastError();
        grid = cus * per_cu; if (grid > 256) grid = 256;
        fprintf(stderr, "kernel_launch: grid %d (cus %d x %d)\n", grid, cus, per_cu);
    }
    if (grid < 0) return;
    if (hipMemsetAsync((char*)d_ws + OFF_BAR, 0, 16384, stream) != hipSuccess) { fprintf(stderr, "kernel_launch: memset failed\n"); return; }
    KArgs a{};
    for (int i = 0; i < 44; ++i) a.in[i] = (const float*)d_in[i];
    a.out = (float*)d_out; a.ws = (unsigned char*)d_ws;
#if MK_ONE_LAUNCH
    a.ph_lo = 0; a.ph_hi = NPH;
    void* args[] = {&a};
    hipError_t e = hipLaunchCooperativeKernel((const void*)fwd_kernel, dim3(grid), dim3(512), args, LDS_BYTES, stream);
    if (e != hipSuccess) fprintf(stderr, "kernel_launch: cooperative launch failed: %s (grid %d)\n", hipGetErrorString(e), grid);
#else
    for (int ph = 0; ph < NPH; ++ph) { a.ph_lo = ph; a.ph_hi = ph + 1; hipLaunchKernelGGL(fwd_kernel, dim3(grid), dim3(512), LDS_BYTES, stream, a); }
#endif
}
```

```cpp
#include <hip/hip_runtime.h>
#include <hip/hip_cooperative_groups.h>
#include <cstdio>
#include <cstdint>
namespace cg = cooperative_groups;
#ifndef GOUT_SPLIT
#define GOUT_SPLIT 0
#endif
__device__ __forceinline__ int otid() { int t = threadIdx.x; asm volatile("" : "+v"(t)); return t; }
namespace pg8 {
#define PG8_LAS __attribute__((address_space(3)))
typedef unsigned short bf16_t;
typedef short bf16x8 __attribute__((ext_vector_type(8)));
typedef float f32x4 __attribute__((ext_vector_type(4)));
typedef unsigned u32x4 __attribute__((ext_vector_type(4)));
constexpr int BM = 256, BK = 64, HALF = 128, HTB = HALF * BK * 2  , STAGE_BYTES = 8 * HTB, NXCD = 8, WGM = 8;

__host__ __device__ __forceinline__ int lds_byte(int r, int c) { const int st = (r >> 4) * 2 + (c >> 5), rr = r & 15, cc = c & 31, ob = rr * 64 + cc * 2; return st * 1024 + (ob ^ (((ob >> 9) & 1) << 5)); }
__host__ __device__ __forceinline__ void stage_rc(int b, int& R, int& C) { const int st = b / 1024, sb = b % 1024, swz = sb ^ (((sb >> 9) & 1) << 5); R = (st >> 1) * 16 + swz / 64; C = (st & 1) * 32 + (swz % 64) / 2; }
__host__ __device__ __forceinline__ int perm32(int rho) { const int n = rho >> 4, i = rho & 15; return 8 * (i >> 2) + 4 * n + (i & 3); }

struct Unit { int pm, pn; };
struct Gemm { const bf16_t* A; const bf16_t* Bt; int M, N, K, ld; };

struct StaticOrder {
    int nM, nN, nwg, G, c; bool skip9 = false;
    __host__ __device__ void init(int M, int N, int G_, int c_) { nM = M / BM; nN = N / BM; nwg = nM * nN; G = G_; c = c_; }
    __host__ __device__ bool next(int i, Unit& u) const {
        const long L = (long)i * G + c; if (L >= nwg) return false;
        int wgid = (int)L; { const int q = nwg / NXCD, r = nwg % NXCD, xcd = wgid % NXCD, off = wgid / NXCD; wgid = (xcd < r ? xcd * (q + 1) : r * (q + 1) + (xcd - r) * q) + off; }
        const int nig = WGM * nN, gid = wgid / nig, fm = gid * WGM, gsz = (nM - fm) < WGM ? (nM - fm) : WGM;
        u.pm = fm + ((wgid % nig) % gsz); u.pn = (wgid % nig) / gsz; if (skip9) u.pm += u.pm >> 3; return true;
    }
    __device__ __forceinline__ void a_ready(const Unit&) const {}
    __device__ __forceinline__ void done(const Unit&) const {}
};
__device__ __forceinline__ unsigned cvt_pk_bf16(float lo, float hi) { unsigned r; asm volatile("v_cvt_pk_bf16_f32 %0, %1, %2" : "=v"(r) : "v"(lo), "v"(hi)); return r; }
template <class Epi, class Sched, bool ALIGN_EPI = false, bool SP2 = false>
__device__ __forceinline__ void gemm_phase(PG8_LAS unsigned char* lds, const Gemm g, const Sched& S, const Epi& E) {
    const int tid = otid(), wid = __builtin_amdgcn_readfirstlane(tid >> 6), lane = tid & 63, wr = wid >> 2, wc = wid & 3, fr = lane & 15, fq = lane >> 4;
    const int K = g.K, nt = K / BK, LD = g.ld;
    unsigned voffA[2], voffB[2];
#pragma unroll
    for (int i = 0; i < 2; ++i) { int R, C; stage_rc(tid * 16 + i * 8192, R, C); const int Rb = Epi::PERM ? ((R & ~31) + perm32(R & 31)) : R;
        voffA[i] = (unsigned)(R * LD + C) * 2u; voffB[i] = (unsigned)(Rb * LD + C) * 2u; }
    const size_t kstep = (size_t)(BK * 2);
    const size_t hstep = (size_t)HALF * LD * 2;
    const size_t tstep = 2 * hstep;
    const unsigned ldsw = (unsigned)wid * 1024u;
    const int aoff = lds_byte(wr * 64 + fr, fq * 8), boff = lds_byte(wc * 32 + fr, fq * 8);
#define PG8_SA(b, h) (((b) * 2 + (h)) * HTB)
#define PG8_SB(b, h) ((4 + (b) * 2 + (h)) * HTB)
#define PG8_STAGE(bufoff, gbase, voff) do { _Pragma("unroll") for (int _i = 0; _i < 2; ++_i) \
        __builtin_amdgcn_global_load_lds((const unsigned*)((const char*)(gbase) + (voff)[_i]), (PG8_LAS unsigned*)(lds + (bufoff) + ldsw + _i * 8192), 16, 0, 0); } while (0)
#define PG8_LDA(dst, b, h) do { _Pragma("unroll") for (int m = 0; m < 4; ++m) _Pragma("unroll") for (int k = 0; k < 2; ++k) dst[m][k] = *(const PG8_LAS bf16x8*)(lds + PG8_SA(b, h) + aoff + m * 2048 + k * 1024); } while (0)
#define PG8_LDB(dst, b, h) do { _Pragma("unroll") for (int n = 0; n < 2; ++n) _Pragma("unroll") for (int k = 0; k < 2; ++k) dst[n][k] = *(const PG8_LAS bf16x8*)(lds + PG8_SB(b, h) + boff + n * 2048 + k * 1024); } while (0)
#define PG8_MMA(ai, bj, At, Bt) do { __builtin_amdgcn_s_setprio(1); _Pragma("unroll") for (int m = 0; m < 4; ++m) _Pragma("unroll") for (int n = 0; n < 2; ++n) _Pragma("unroll") for (int k = 0; k < 2; ++k) \
        acc[ai][bj][m][n] = __builtin_amdgcn_mfma_f32_16x16x32_bf16(Bt[n][k], At[m][k], acc[ai][bj][m][n], 0, 0, 0); __builtin_amdgcn_s_setprio(0); } while (0)
#define PG8_WAIT_V(n) asm volatile("s_waitcnt vmcnt(" #n ")" ::: "memory")
#define PG8_WAIT_L(n) asm volatile("s_waitcnt lgkmcnt(" #n ")" ::: "memory")
#define PG8_BAR __builtin_amdgcn_s_barrier()
#define PG8_SCHED __builtin_amdgcn_sched_barrier(0)
    Unit cur, nxt; int ui = 0;
    if (!S.next(0, cur)) return;
    f32x4 acc[2][2][4][2];
#pragma unroll
    for (int a = 0; a < 2; ++a)
#pragma unroll
        for (int b = 0; b < 2; ++b)
#pragma unroll
            for (int m = 0; m < 4; ++m)
#pragma unroll
                for (int n = 0; n < 2; ++n) acc[a][b][m][n] = (f32x4){0.f, 0.f, 0.f, 0.f};
    bf16x8 At[4][2], B0[2][2], B1[2][2];
    const char* cA = (const char*)g.A + (size_t)cur.pm * tstep; const char* cB = (const char*)g.Bt + (size_t)cur.pn * tstep;
    S.a_ready(cur);
    if constexpr (SP2) {
        PG8_STAGE(PG8_SB(0, 0), cB, voffB); PG8_STAGE(PG8_SB(0, 1), cB + hstep, voffB); PG8_STAGE(PG8_SA(0, 0), cA, voffA); PG8_STAGE(PG8_SA(0, 1), cA + hstep, voffA);
        if (wr == 1) PG8_BAR;
        PG8_WAIT_V(2); PG8_BAR;
        PG8_STAGE(PG8_SB(1, 0), cB + kstep, voffB); PG8_STAGE(PG8_SA(1, 0), cA + kstep, voffA); PG8_STAGE(PG8_SB(1, 1), cB + hstep + kstep, voffB);
        PG8_WAIT_V(6); PG8_BAR;
    } else {
        PG8_STAGE(PG8_SB(0, 0), cB, voffB); PG8_STAGE(PG8_SA(0, 0), cA, voffA); PG8_STAGE(PG8_SB(0, 1), cB + hstep, voffB); PG8_STAGE(PG8_SA(0, 1), cA + hstep, voffA);
        if (wr == 1) PG8_BAR;
        PG8_WAIT_V(4); PG8_BAR;
        PG8_STAGE(PG8_SB(1, 0), cB + kstep, voffB); PG8_STAGE(PG8_SA(1, 0), cA + kstep, voffA); PG8_STAGE(PG8_SB(1, 1), cB + hstep + kstep, voffB);
        PG8_WAIT_V(6); PG8_BAR;
    }
    for (;;) {
        const bool has_next = S.next(ui + 1, nxt);
        const char* nA = has_next ? (const char*)g.A + (size_t)nxt.pm * tstep : cA; const char* nB = has_next ? (const char*)g.Bt + (size_t)nxt.pn * tstep : cB;
        for (int t = 0; t < nt; t += 2) {
            const bool last = (t == nt - 2);
            const char* a1 = cA + (size_t)(t + 1) * kstep;
            const char* a2 = last ? nA : cA + (size_t)(t + 2) * kstep; const char* b2 = last ? nB : cB + (size_t)(t + 2) * kstep;
            const char* a3 = a2 + kstep; const char* b3 = b2 + kstep;
            if (last && has_next) S.a_ready(nxt);
            if constexpr (SP2) {
            PG8_LDB(B0, 0, 0); PG8_LDB(B1, 0, 1); PG8_SCHED; PG8_LDA(At, 0, 0); PG8_STAGE(PG8_SA(1, 1), a1 + hstep, voffA);
            PG8_WAIT_V(8); PG8_WAIT_L(0); PG8_BAR; PG8_MMA(0, 0, At, B0); PG8_MMA(0, 1, At, B1); PG8_BAR; PG8_SCHED;
            PG8_LDA(At, 0, 1); PG8_STAGE(PG8_SB(0, 0), b2, voffB); PG8_STAGE(PG8_SB(0, 1), b2 + hstep, voffB); PG8_STAGE(PG8_SA(0, 0), a2, voffA);
            PG8_WAIT_V(8); PG8_WAIT_L(0); PG8_BAR; PG8_MMA(1, 0, At, B0); PG8_MMA(1, 1, At, B1); PG8_BAR; PG8_SCHED;
            PG8_LDB(B0, 1, 0); PG8_LDB(B1, 1, 1); PG8_SCHED; PG8_LDA(At, 1, 0); PG8_STAGE(PG8_SA(0, 1), a2 + hstep, voffA);
            PG8_WAIT_V(8); PG8_WAIT_L(0); PG8_BAR; PG8_MMA(0, 0, At, B0); PG8_MMA(0, 1, At, B1); PG8_BAR; PG8_SCHED;
            PG8_LDA(At, 1, 1); PG8_STAGE(PG8_SB(1, 0), b3, voffB); PG8_STAGE(PG8_SB(1, 1), b3 + hstep, voffB); PG8_STAGE(PG8_SA(1, 0), a3, voffA);
            PG8_WAIT_V(8); PG8_WAIT_L(0); PG8_BAR; PG8_MMA(1, 0, At, B0); PG8_MMA(1, 1, At, B1); PG8_BAR; PG8_SCHED;
            } else {
            PG8_LDB(B0, 0, 0); PG8_SCHED; PG8_LDA(At, 0, 0); PG8_STAGE(PG8_SA(1, 1), a1 + hstep, voffA);
            PG8_WAIT_L(8); PG8_BAR; PG8_WAIT_L(0); PG8_MMA(0, 0, At, B0); PG8_BAR; PG8_SCHED;
            PG8_LDB(B1, 0, 1); PG8_STAGE(PG8_SB(0, 0), b2, voffB);
            PG8_BAR; PG8_WAIT_L(0); PG8_MMA(0, 1, At, B1); PG8_BAR;
            PG8_LDA(At, 0, 1); PG8_STAGE(PG8_SA(0, 0), a2, voffA);
            PG8_BAR; PG8_WAIT_L(0); PG8_MMA(1, 0, At, B0); PG8_BAR; PG8_SCHED;
            PG8_STAGE(PG8_SB(0, 1), b2 + hstep, voffB);
            PG8_WAIT_V(6); PG8_BAR; PG8_MMA(1, 1, At, B1); PG8_BAR;
            PG8_LDB(B0, 1, 0); PG8_SCHED; PG8_LDA(At, 1, 0); PG8_STAGE(PG8_SA(0, 1), a2 + hstep, voffA);
            PG8_WAIT_L(8); PG8_BAR; PG8_WAIT_L(0); PG8_MMA(0, 0, At, B0); PG8_BAR; PG8_SCHED;
            PG8_LDB(B1, 1, 1); PG8_STAGE(PG8_SB(1, 0), b3, voffB);
            PG8_BAR; PG8_WAIT_L(0); PG8_MMA(0, 1, At, B1); PG8_BAR;
            PG8_LDA(At, 1, 1); PG8_STAGE(PG8_SA(1, 0), a3, voffA);
            PG8_BAR; PG8_WAIT_L(0); PG8_MMA(1, 0, At, B0); PG8_BAR; PG8_SCHED;
            PG8_STAGE(PG8_SB(1, 1), b3 + hstep, voffB);
            PG8_WAIT_V(6); PG8_BAR; PG8_MMA(1, 1, At, B1); PG8_BAR;
            }
        }
        if constexpr (ALIGN_EPI) { if (wr == 0) PG8_BAR; }
        if constexpr (!Epi::AFTER_DRAIN) { E(acc, cur, wr, wc, fr, fq); S.done(cur); }
        if (!has_next) break;
#pragma unroll
        for (int a = 0; a < 2; ++a)
#pragma unroll
            for (int b = 0; b < 2; ++b)
#pragma unroll
                for (int m = 0; m < 4; ++m)
#pragma unroll
                    for (int n = 0; n < 2; ++n) acc[a][b][m][n] = (f32x4){0.f, 0.f, 0.f, 0.f};
        cur = nxt; cA = nA; cB = nB; ++ui;
        if constexpr (ALIGN_EPI) { if (wr == 1) PG8_BAR; }
    }
    PG8_WAIT_V(0);
    if constexpr (!ALIGN_EPI) { if (wr == 0) PG8_BAR; }
    PG8_BAR;
    if constexpr (Epi::AFTER_DRAIN) { E.fused(acc, cur, wr, wc, fr, fq, lds, wid, lane); S.done(cur); }
#undef PG8_SA
#undef PG8_SB
#undef PG8_STAGE
#undef PG8_LDA
#undef PG8_LDB
#undef PG8_MMA
#undef PG8_WAIT_V
#undef PG8_WAIT_L
#undef PG8_BAR
#undef PG8_SCHED
}
}

constexpr int NB = 8, SEQ = 2048, CTXL = 256, TB = SEQ + CTXL  , MROWS = NB * TB  , DM = 2048;
constexpr float NORM_EPS = 1e-6f;
constexpr int NWAVES = 8;
constexpr int LDS_BYTES = 155648;
constexpr size_t MiB = 1u << 20;
constexpr size_t OFF_ADA = 0;
constexpr size_t OFF_BAR = 960 * 1024;
constexpr size_t OFF_WIN0 = 1 * MiB;
constexpr size_t OFF_WIN1 = OFF_WIN0 + 32 * MiB;
constexpr size_t OFF_WIN2 = OFF_WIN1 + 20 * MiB;
constexpr size_t OFF_WIN3 = OFF_WIN2 + 13 * MiB;
constexpr size_t OFF_WOUT = OFF_WIN3 + 32 * MiB;
constexpr size_t OFF_WQB = OFF_WOUT + 32 * MiB;
constexpr size_t OFF_WKVB = OFF_WQB + 3 * MiB;
constexpr size_t OFF_HCTX = OFF_WKVB + 4 * MiB;
constexpr size_t OFF_KR = OFF_HCTX + 16 * MiB;
constexpr size_t OFF_XN = OFF_KR + 3 * MiB;
constexpr size_t OFF_Q = OFF_XN + 72 * MiB;
constexpr size_t OFF_K = OFF_Q + 108 * MiB;
constexpr size_t OFF_V = OFF_K + 72 * MiB;
constexpr size_t OFF_G = OFF_V + 72 * MiB;
constexpr size_t WS_END = OFF_G + 72 * MiB;
constexpr int ADA_SPLIT = 16;

#define GAS __attribute__((address_space(1)))
#define LAS __attribute__((address_space(3)))
typedef unsigned short bf16_t;
typedef unsigned v4u __attribute__((ext_vector_type(4)));
typedef unsigned v2u __attribute__((ext_vector_type(2)));
typedef float f32x4 __attribute__((ext_vector_type(4)));
#define LDS_WAIT() asm volatile("s_waitcnt lgkmcnt(0)" ::: "memory")
__device__ __forceinline__ unsigned f2bf(float f) { unsigned u = __builtin_bit_cast(unsigned, f); return (u + 0x7fffu + ((u >> 16) & 1u)) >> 16; }
__device__ __forceinline__ unsigned pk2(float lo, float hi) { return f2bf(lo) | (f2bf(hi) << 16); }
__device__ __forceinline__ float bflo(unsigned w) { return __builtin_bit_cast(float, w << 16); }
__device__ __forceinline__ float bfhi(unsigned w) { return __builtin_bit_cast(float, w & 0xffff0000u); }
__device__ __forceinline__ float bf1(bf16_t h) { return __builtin_bit_cast(float, (unsigned)h << 16); }
__device__ __forceinline__ float wave_sum(float v) {
#pragma unroll
    for (int o = 1; o < 64; o <<= 1) v += __shfl_xor(v, o);
    return v;
}
__device__ __forceinline__ float silu_f(float x) { return x * __builtin_amdgcn_rcpf(1.f + __expf(-x)); }

enum { PH_PRO = 0, PH_ADA,
       PH_L0_ROW, PH_L0_GIN, PH_L0_ATT, PH_L0_GOUT,
       PH_L1_ROW, PH_L1_GIN, PH_L1_POST, PH_L1_ATT, PH_L1_GOUT,
       PH_L2_ROW, PH_L2_GIN, PH_L2_POST, PH_L2_GQ, PH_L2_GKV, PH_L2_ATT, PH_L2_GOUT,
       PH_L3_ROW, PH_L3_GIN, PH_L3_ATT, PH_L3_GOUT, PH_FIN, NPH };

struct EpiRoute {
    static constexpr bool PERM = true, AFTER_DRAIN = false;
    int ph; unsigned char* ws;
    __device__ __forceinline__ void operator()(const pg8::f32x4 (&acc)[2][2][4][2], const pg8::Unit& u, int wr, int wc, int fr, int fq) const {
        int ph_ = ph; asm volatile("" : "+s"(ph_));
        constexpr int BIG = 1 << 29;
        bf16_t* Qb = (bf16_t*)(ws + OFF_Q); bf16_t* Kb = (bf16_t*)(ws + OFF_K); bf16_t* Vb = (bf16_t*)(ws + OFF_V); bf16_t* Gb = (bf16_t*)(ws + OFF_G);
        int c1 = BIG, c2 = BIG, c3 = BIG, ld0 = 2048, ld1 = 2048, ld2 = 2048, ld3 = 2048, rope0 = 0, rope1 = 0, nvalid = BIG, mode = 0;
        bf16_t *d0 = Qb, *d1 = Qb, *d2 = Qb, *d3 = Qb;
        float qs0 = 1.f;
        if (ph_ == PH_L0_GIN || ph_ == PH_L3_GIN) { c1 = 2048; c2 = 4096; c3 = 6144; d1 = Kb; d2 = Vb; d3 = Gb; rope0 = rope1 = 1; qs0 = 0.125f * 1.4426950408889634f; }
        else if (ph_ == PH_L1_GIN) { c1 = 2048; c2 = 2560; c3 = 3072; d1 = Kb; ld1 = 512; d2 = Vb; ld2 = 512; d3 = Gb; }
        else if (ph_ == PH_L2_GIN) { d0 = Vb; ld0 = 1088; c1 = 1088; d1 = Gb; nvalid = 3136; }
        else if (ph_ == PH_L2_GQ) { ld0 = 3072; rope0 = 2; }
        else if (ph_ == PH_L2_GKV) { mode = 1; d0 = Kb; d1 = Vb; }
        const int tb = u.pm % 9; const bool lat = tb < 8;
        float invf[4];
#pragma unroll
        for (int e = 0; e < 4; ++e) invf[e] = __builtin_amdgcn_exp2f(-(float)(4 * fq + e) * (13.287712379549449f / 16.f));
#pragma unroll
        for (int bj = 0; bj < 2; ++bj) {
            const int c0 = u.pn * 256 + bj * 128 + wc * 32;
            if (c0 >= nvalid) continue;
            bf16_t* dst; int ld, cl, rope; float scl = 1.f;
            if (mode == 1) { dst = bj ? d1 : d0; ld = 2048; cl = u.pn * 128 + wc * 32; rope = 0; }
            else if (c0 >= c3) { dst = d3; ld = ld3; cl = c0 - c3; rope = 0; }
            else if (c0 >= c2) { dst = d2; ld = ld2; cl = c0 - c2; rope = 0; }
            else if (c0 >= c1) { dst = d1; ld = ld1; cl = c0 - c1; rope = rope1; }
            else { dst = d0; ld = ld0; cl = c0; rope = rope0; scl = qs0; }
            const bool rp = lat && (rope == 1 || (rope == 2 && (c0 % 192) >= 128));
            const int par = (c0 >> 5) & 1;
            dst += cl + 8 * fq;
#pragma unroll
            for (int ai = 0; ai < 2; ++ai)
#pragma unroll
                for (int m = 0; m < 4; ++m) {
                    const size_t row = (size_t)u.pm * 256 + ai * 128 + wr * 64 + m * 16 + fr;
                    pg8::f32x4 v0 = acc[ai][bj][m][0] * scl, v1 = acc[ai][bj][m][1] * scl;
                    if (rp) {
                        const float pos = par ? (float)(16 * m + fr) : (float)(tb * 4 + 2 * ai + wr);
#pragma unroll
                        for (int e = 0; e < 4; ++e) { const float ang = pos * invf[e]; const float sn = __sinf(ang), cs = __cosf(ang);
                            const float a = v0[e], b = v1[e]; v0[e] = a * cs - b * sn; v1[e] = a * sn + b * cs; }
                    }
                    v4u w; w.x = pg8::cvt_pk_bf16(v0[0], v0[1]); w.y = pg8::cvt_pk_bf16(v0[2], v0[3]); w.z = pg8::cvt_pk_bf16(v1[0], v1[1]); w.w = pg8::cvt_pk_bf16(v1[2], v1[3]);
                    *(v4u*)(dst + row * ld) = w;
                }
        }
    }
};

#ifndef ATT_ASYM
#define ATT_ASYM 0
#endif
namespace att {
using bf16x8 = __attribute__((ext_vector_type(8))) short;
using s16x4  = __attribute__((ext_vector_type(4))) short;
using f32x16 = __attribute__((ext_vector_type(16))) float;
using u32x4  = __attribute__((ext_vector_type(4))) unsigned;
constexpr int NW = 8, QBLK = 32, KVBLK = 64;
constexpr float THR = 8.f;
constexpr int SHM_V = KVBLK * 128 * 2;
#define SBAR() __builtin_amdgcn_sched_barrier(0)
__device__ __forceinline__ int crow(int r, int hi) { return (r & 3) + 8 * (r >> 2) + 4 * hi; }
__device__ __forceinline__ unsigned cvtpk(float lo, float hi) { unsigned r; asm volatile("v_cvt_pk_bf16_f32 %0, %1, %2" : "=v"(r) : "v"(lo), "v"(hi)); return r; }
template <int DQK> struct Sc { static constexpr float SCALE = DQK == 64 ? 0.125f : (DQK == 128 ? 0.088388347648318440f : 0.072168783648703220f); };
template <int KW> __device__ __forceinline__ int kswz(int row, int colB) { return row * (KW * 2) + (colB ^ ((row & 7) << 4)); }

template <int DQK> __device__ __forceinline__ void partialSM(f32x16& p0, f32x16& p1, float& m_reg, float& mn, float& alpha) {
  constexpr float SCALE = Sc<DQK>::SCALE; constexpr float C = SCALE * 1.4426950408889634f;
  float pmax = p0[0];
#pragma unroll
  for (int r = 1; r < 16; ++r) pmax = fmaxf(pmax, p0[r]);
#pragma unroll
  for (int r = 0; r < 16; ++r) pmax = fmaxf(pmax, p1[r]);
  { auto rr = __builtin_amdgcn_permlane32_swap(__float_as_uint(pmax), __float_as_uint(pmax), false, false);
    pmax = fmaxf(__uint_as_float(rr[0]), __uint_as_float(rr[1])); }
  if (__builtin_expect(__all(pmax - m_reg <= THR / SCALE), 1)) { mn = m_reg; alpha = 1.f; }
  else { mn = fmaxf(m_reg, pmax); alpha = __builtin_amdgcn_exp2f((m_reg - mn) * C); m_reg = mn; }
  float mnC = -mn * C;
#pragma unroll
  for (int r = 0; r < 16; ++r) p0[r] = fmaf(p0[r], C, mnC);
#pragma unroll
  for (int r = 0; r < 16; ++r) p1[r] = fmaf(p1[r], C, mnC);
#pragma unroll
  for (int r = 0; r < 16; ++r) p0[r] = __builtin_amdgcn_exp2f(p0[r]);
}
constexpr float THRL = THR * 1.4426950408889634f;
template <bool FIRST> __device__ __forceinline__ void partialSM_ps(f32x16& p0, f32x16& p1, float& m_reg, float& alpha, f32x16& negm) {
  float pmax = p0[0];
#pragma unroll
  for (int r = 1; r < 16; ++r) pmax = fmaxf(pmax, p0[r]);
#pragma unroll
  for (int r = 0; r < 16; ++r) pmax = fmaxf(pmax, p1[r]);
  { auto rr = __builtin_amdgcn_permlane32_swap(__float_as_uint(pmax), __float_as_uint(pmax), false, false);
    pmax = fmaxf(__uint_as_float(rr[0]), __uint_as_float(rr[1])); }
  alpha = 1.f;
  if (FIRST || !__builtin_expect(__all(pmax <= THRL), 1)) {
    const float dl = FIRST ? pmax : fmaxf(pmax, 0.f); m_reg += dl;
#pragma unroll
    for (int r = 0; r < 16; ++r) { p0[r] -= dl; p1[r] -= dl; }
    if (!FIRST) alpha = __builtin_amdgcn_exp2f(-dl);
#pragma unroll
    for (int r = 0; r < 16; ++r) negm[r] = -m_reg;
    asm volatile("" : "+v"(negm));
  }
#pragma unroll
  for (int r = 0; r < 16; ++r) p0[r] = __builtin_amdgcn_exp2f(p0[r]);
}
__device__ __forceinline__ void finishSM(f32x16& p0, f32x16& p1, float alpha, float& l_reg, bf16x8& pa0, bf16x8& pa1, bf16x8& pa2, bf16x8& pa3) {
#pragma unroll
  for (int r = 0; r < 16; ++r) p1[r] = __builtin_amdgcn_exp2f(p1[r]);
  float ps = 0;
#pragma unroll
  for (int r = 0; r < 16; ++r) ps += p0[r];
#pragma unroll
  for (int r = 0; r < 16; ++r) ps += p1[r];
  { auto rr = __builtin_amdgcn_permlane32_swap(__float_as_uint(ps), __float_as_uint(ps), false, false);
    ps = __uint_as_float(rr[0]) + __uint_as_float(rr[1]); }
  l_reg = l_reg * alpha + ps;
#define PK4(P, BASE, OUT) do { unsigned a0 = cvtpk(P[BASE + 0], P[BASE + 1]), a1 = cvtpk(P[BASE + 2], P[BASE + 3]);   \
    unsigned b0 = cvtpk(P[BASE + 4], P[BASE + 5]), b1 = cvtpk(P[BASE + 6], P[BASE + 7]);                              \
    auto r0 = __builtin_amdgcn_permlane32_swap(a0, b0, false, false); auto r1 = __builtin_amdgcn_permlane32_swap(a1, b1, false, false); \
    u32x4 w = {r0[0], r1[0], r0[1], r1[1]}; OUT = *reinterpret_cast<bf16x8*>(&w); } while (0)
  PK4(p0, 0, pa0); PK4(p0, 8, pa1); PK4(p1, 0, pa2); PK4(p1, 8, pa3);
#undef PK4
}
template <int DQK, int KW, int QSP> __device__ __forceinline__ void qkt(f32x16& p0, f32x16& p1, const char* Ks, const int (&kb)[4], const bf16x8* qr, const char* qsp, const f32x16& cinit) {
  p0 = cinit; p1 = cinit;
  constexpr int N = DQK / 16;
#define KRD(d, lo) (*reinterpret_cast<const bf16x8*>(Ks + kb[(d) & 3] + ((d) >> 2) * 128 + ((lo) ? 0 : 32 * KW * 2)))
  bf16x8 f0[2], f1[2];
  f0[0] = KRD(0, 1); f1[0] = KRD(0, 0);
#pragma unroll
  for (int d0 = 0; d0 < N; ++d0) {
    if (d0 + 1 < N) { f0[(d0 + 1) & 1] = KRD(d0 + 1, 1); f1[(d0 + 1) & 1] = KRD(d0 + 1, 0); }
    __builtin_amdgcn_sched_barrier(0x406);
    bf16x8 qf;
    if constexpr (QSP > 0) { if (d0 >= N - QSP) qf = *reinterpret_cast<const bf16x8*>(qsp + (d0 - (N - QSP)) * 1024); else qf = qr[d0]; } else qf = qr[d0];
    p0 = __builtin_amdgcn_mfma_f32_32x32x16_bf16(f0[d0 & 1], qf, p0, 0, 0, 0);
    p1 = __builtin_amdgcn_mfma_f32_32x32x16_bf16(f1[d0 & 1], qf, p1, 0, 0, 0);
    __builtin_amdgcn_sched_barrier(0x406); }
#undef KRD
}
__device__ __forceinline__ int v_st(int k, int c) { const int kk = (k & ~0xC) | ((k & 4) << 1) | ((k & 8) >> 1); return ((kk >> 3) * 4 + (c >> 5)) * 512 + ((kk & 7) * 32 + (c & 31)) * 2; }
__device__ __forceinline__ int v_rd_base(int lane) { return ((lane & 3) << 3) | (((lane >> 2) & 3) << 6) | (((lane >> 4) & 1) << 5) | (((lane >> 5) & 1) << 8); }
constexpr int v_rd_off(int d0, int ks, int half) { return d0 * 512 + ks * 4096 + half * 2048; }
template <int OFF> __device__ __forceinline__ s16x4 tr_read(int vb) {
  s16x4 r; asm volatile("ds_read_b64_tr_b16 %0, %1 offset:%2" : "=&v"(r) : "v"(vb), "i"(OFF) : "memory"); return r;
}
template <int D0> __device__ __forceinline__ void pv_one(f32x16& od, int vb, bf16x8 pa0, bf16x8 pa1, bf16x8 pa2, bf16x8 pa3) {
  const s16x4 l0 = tr_read<v_rd_off(D0, 0, 0)>(vb), h0 = tr_read<v_rd_off(D0, 0, 1)>(vb), l1 = tr_read<v_rd_off(D0, 1, 0)>(vb), h1 = tr_read<v_rd_off(D0, 1, 1)>(vb);
  const s16x4 l2 = tr_read<v_rd_off(D0, 2, 0)>(vb), h2 = tr_read<v_rd_off(D0, 2, 1)>(vb), l3 = tr_read<v_rd_off(D0, 3, 0)>(vb), h3 = tr_read<v_rd_off(D0, 3, 1)>(vb);
  asm volatile("s_waitcnt lgkmcnt(0)" ::: "memory"); SBAR();
#define PK(L, H) (bf16x8){L[0], L[1], L[2], L[3], H[0], H[1], H[2], H[3]}
  od = __builtin_amdgcn_mfma_f32_32x32x16_bf16(pa0, PK(l0, h0), od, 0, 0, 0);
  od = __builtin_amdgcn_mfma_f32_32x32x16_bf16(pa1, PK(l1, h1), od, 0, 0, 0);
  od = __builtin_amdgcn_mfma_f32_32x32x16_bf16(pa2, PK(l2, h2), od, 0, 0, 0);
  od = __builtin_amdgcn_mfma_f32_32x32x16_bf16(pa3, PK(l3, h3), od, 0, 0, 0);
#undef PK
}
__device__ __forceinline__ void pv_d0(f32x16* o, int vb, bf16x8 pa0, bf16x8 pa1, bf16x8 pa2, bf16x8 pa3) {
  pv_one<0>(o[0], vb, pa0, pa1, pa2, pa3); pv_one<1>(o[1], vb, pa0, pa1, pa2, pa3); pv_one<2>(o[2], vb, pa0, pa1, pa2, pa3); pv_one<3>(o[3], vb, pa0, pa1, pa2, pa3);
}
struct VF { s16x4 l0, h0, l1, h1, l2, h2, l3, h3; };
template <int D0> __device__ __forceinline__ void vf_read(VF& f, int vb) {
  f.l0 = tr_read<v_rd_off(D0, 0, 0)>(vb); f.h0 = tr_read<v_rd_off(D0, 0, 1)>(vb); f.l1 = tr_read<v_rd_off(D0, 1, 0)>(vb); f.h1 = tr_read<v_rd_off(D0, 1, 1)>(vb);
  f.l2 = tr_read<v_rd_off(D0, 2, 0)>(vb); f.h2 = tr_read<v_rd_off(D0, 2, 1)>(vb); f.l3 = tr_read<v_rd_off(D0, 3, 0)>(vb); f.h3 = tr_read<v_rd_off(D0, 3, 1)>(vb);
}
__device__ __forceinline__ void vf_mma(f32x16& od, const VF& f, bf16x8 pa0, bf16x8 pa1, bf16x8 pa2, bf16x8 pa3) {
#define PK(L, H) (bf16x8){L[0], L[1], L[2], L[3], H[0], H[1], H[2], H[3]}
  od = __builtin_amdgcn_mfma_f32_32x32x16_bf16(pa0, PK(f.l0, f.h0), od, 0, 0, 0);
  od = __builtin_amdgcn_mfma_f32_32x32x16_bf16(pa1, PK(f.l1, f.h1), od, 0, 0, 0);
  od = __builtin_amdgcn_mfma_f32_32x32x16_bf16(pa2, PK(f.l2, f.h2), od, 0, 0, 0);
  od = __builtin_amdgcn_mfma_f32_32x32x16_bf16(pa3, PK(f.l3, f.h3), od, 0, 0, 0);
#undef PK
}
__device__ __forceinline__ void pv_d0_pipe(f32x16* o, int vb, bf16x8 pa0, bf16x8 pa1, bf16x8 pa2, bf16x8 pa3) {
  VF fa, fb;
  SBAR(); vf_read<0>(fa, vb); vf_read<1>(fb, vb);
  asm volatile("s_waitcnt lgkmcnt(8)" ::: "memory"); SBAR(); vf_mma(o[0], fa, pa0, pa1, pa2, pa3); SBAR();
  vf_read<2>(fa, vb); asm volatile("s_waitcnt lgkmcnt(8)" ::: "memory"); SBAR(); vf_mma(o[1], fb, pa0, pa1, pa2, pa3); SBAR();
  vf_read<3>(fb, vb); asm volatile("s_waitcnt lgkmcnt(8)" ::: "memory"); SBAR(); vf_mma(o[2], fa, pa0, pa1, pa2, pa3); SBAR();
  asm volatile("s_waitcnt lgkmcnt(0)" ::: "memory"); SBAR(); vf_mma(o[3], fb, pa0, pa1, pa2, pa3);
}

struct UnitP {
  const bf16_t* Qw;  int ldq;
  const bf16_t* K0;  int ldk0;
  const bf16_t* K1;  int ldk1;
  const bf16_t* Vh;  int ldv;
  const bf16_t* Gw;
  bf16_t* Ow;
  int nt;
  float lam, osc;
  const float* subg;
};

template <int DQK, int KW, bool DIFF, int SDEPTH, int QSP, int NBUF>
__device__ __forceinline__ void attn_unit(const UnitP& P, char* lds) {
  constexpr int SHM_K = KVBLK * KW * 2, NKC = KW / 64;
  const int tid = otid(), wid = tid >> 6, lane = tid & 63, r32 = lane & 31, hi = lane >> 5;
  char* V_lds = lds; char* K_lds = lds + NBUF * SHM_V;
  float* ws = (float*)(lds + NBUF * (SHM_V + SHM_K)) + wid * 64; float* li_l = ws; float* al_l = ws + 32;
  float m_reg = DIFF ? 0.f : -1e30f, l_reg = 0; f32x16 o[4] = {}; f32x16 negm = {}; if constexpr (DIFF) asm volatile("" : "+v"(negm));    constexpr int NQR = DQK / 16 - QSP; bf16x8 qr[NQR > 0 ? NQR : 1];
  char* qsp = lds + NBUF * (SHM_V + SHM_K) + 2048 + wid * (QSP * 1024) + lane * 16;
  const int coffB = DIFF ? (wid >> 2) * 128 : 0;
  { const bf16_t* Qp = P.Qw + (long)r32 * P.ldq + hi * 8;
#pragma unroll
    for (int d0 = 0; d0 < NQR; ++d0) qr[d0] = *reinterpret_cast<const bf16x8*>(Qp + d0 * 16);
#pragma unroll
    for (int d0 = NQR; d0 < DQK / 16; ++d0) *reinterpret_cast<bf16x8*>(qsp + (d0 - NQR) * 1024) = *reinterpret_cast<const bf16x8*>(Qp + d0 * 16); }
  const int sr = tid >> 4, sc = (tid & 15) * 8, vst0 = v_st(sr, sc), vst1 = v_st(32 + sr, sc);
  const int vb0 = (int)(uintptr_t)V_lds + v_rd_base(lane);
  int kb[4];
#pragma unroll
  for (int q = 0; q < 4; ++q) kb[q] = coffB + kswz<KW>(r32, q * 32 + hi * 16);
  const unsigned voff = (unsigned)(sr * P.ldv + sc) * 2u, koff = (unsigned)(sr * P.ldk0 + sc) * 2u, koff2 = (unsigned)((tid >> 3) * P.ldk1 + (tid & 7) * 8) * 2u;
  const int kdst0 = kswz<KW>(sr, sc * 2), kdst2 = kswz<KW>(tid >> 3, 256 + (tid & 7) * 16);
  struct { bf16x8 vs0, vs1, ks0, ks1, ks2; } sr_[SDEPTH];
#define SLOAD(i, t) do { const char* vt_ = (const char*)P.Vh + (size_t)(t) * (KVBLK * 2) * P.ldv; const char* kt_ = (const char*)P.K0 + (size_t)(t) * (KVBLK * 2) * P.ldk0; \
    sr_[i].vs0 = *reinterpret_cast<const bf16x8*>(vt_ + voff); sr_[i].vs1 = *reinterpret_cast<const bf16x8*>(vt_ + (size_t)64 * P.ldv + voff); \
    sr_[i].ks0 = *reinterpret_cast<const bf16x8*>(kt_ + koff); sr_[i].ks1 = *reinterpret_cast<const bf16x8*>(kt_ + (size_t)64 * P.ldk0 + koff); \
    if constexpr (KW == 192) sr_[i].ks2 = *reinterpret_cast<const bf16x8*>((const char*)P.K1 + (size_t)(t) * (KVBLK * 2) * P.ldk1 + koff2); } while (0)
#define SWRITE(b, i) do { *(bf16x8*)(V_lds + (b) * SHM_V + vst0) = sr_[i].vs0; *(bf16x8*)(V_lds + (b) * SHM_V + vst1) = sr_[i].vs1; \
    *(bf16x8*)(K_lds + (b) * SHM_K + kdst0) = sr_[i].ks0; *(bf16x8*)(K_lds + (b) * SHM_K + kdst0 + 32 * KW * 2) = sr_[i].ks1; \
    if constexpr (KW == 192) *(bf16x8*)(K_lds + (b) * SHM_K + kdst2) = sr_[i].ks2; } while (0)
#define SWAIT() do { if constexpr (SDEPTH == 2) { if constexpr (NKC == 2) asm volatile("s_waitcnt vmcnt(4)" ::: "memory"); else asm volatile("s_waitcnt vmcnt(5)" ::: "memory"); } \
    else asm volatile("s_waitcnt vmcnt(0)" ::: "memory"); } while (0)
#define RESC(a) do { if (__any((a) < 1.f)) { if (hi == 0) al_l[r32] = (a); asm volatile("s_waitcnt lgkmcnt(0)" ::: "memory"); \
    _Pragma("unroll") for (int d = 0; d < 4; ++d) _Pragma("unroll") for (int r = 0; r < 16; ++r) o[d][r] *= al_l[crow(r, hi)]; } } while (0)
#define PVD0(...) do { pv_d0(__VA_ARGS__); } while (0)
#define PSM(X0, X1, MN, AL, FIRST) do { if constexpr (DIFF) partialSM_ps<FIRST>(X0, X1, m_reg, AL, negm); else partialSM<DQK>(X0, X1, m_reg, MN, AL); } while (0)
  f32x16 pA0, pA1, pB0, pB1; float mnA, mnB, alA, alB; bf16x8 pa0, pa1, pa2, pa3; const int NT = P.nt;
  if constexpr (NBUF == 3) {
#define VM0() asm volatile("s_waitcnt vmcnt(0)" ::: "memory")
#define WGBAR() asm volatile("s_waitcnt lgkmcnt(0)\n\ts_barrier" ::: "memory")
#define RSTEP(C0, C1, MNC, ALC, P0, P1, ALP, WR, LD, TNEXT2) do { \
      SBAR(); qkt<DQK, KW, QSP>(C0, C1, K_lds + rcur * SHM_K, kb, qr, qsp, negm); \
      finishSM(P0, P1, ALP, l_reg, pa0, pa1, pa2, pa3); SBAR(); \
      if (WR) { VM0(); SWRITE(rnext, 0); } if (LD) SLOAD(0, (TNEXT2)); SBAR(); \
      PVD0(o, vb0 + rprev * SHM_V, pa0, pa1, pa2, pa3); PSM(C0, C1, MNC, ALC, false); \
      WGBAR(); RESC(ALC); \
      rprev = rcur; rcur = rnext; rnext = (rnext == 2) ? 0 : rnext + 1; } while (0)
    int rprev = 0, rcur = 1, rnext = 2;
    SLOAD(0, 0); VM0(); SWRITE(0, 0); SLOAD(0, 1); WGBAR();
    qkt<DQK, KW, QSP>(pA0, pA1, K_lds, kb, qr, qsp, negm); PSM(pA0, pA1, mnA, alA, true);
    VM0(); SWRITE(1, 0); if (2 < NT) SLOAD(0, 2); WGBAR();
    for (int j = 1; j + 1 < NT; j += 2) {
      RSTEP(pB0, pB1, mnB, alB, pA0, pA1, alA, true, true, j + 2);
      RSTEP(pA0, pA1, mnA, alA, pB0, pB1, alB, true, (j + 3 < NT), j + 3);
    }
    RSTEP(pB0, pB1, mnB, alB, pA0, pA1, alA, false, false, 0);
    finishSM(pB0, pB1, alB, l_reg, pa0, pa1, pa2, pa3); SBAR();
    PVD0(o, vb0 + rprev * SHM_V, pa0, pa1, pa2, pa3);
#undef RSTEP
#undef VM0
#undef WGBAR
  } else {
  constexpr int SE = 0, SO = SDEPTH - 1;
  SLOAD(SE, 0); asm volatile("s_waitcnt vmcnt(0)" ::: "memory"); SWRITE(0, SE); __syncthreads();
  qkt<DQK, KW, QSP>(pA0, pA1, K_lds, kb, qr, qsp, negm); PSM(pA0, pA1, mnA, alA, true);
  SLOAD(SO, 1); if constexpr (SDEPTH == 2) { if (2 < NT) SLOAD(SE, 2); }
  SWAIT(); SWRITE(1, SO); __syncthreads();
  if (ATT_ASYM == 0 || wid < 4) {
  for (int j = 1; j + 1 < NT; j += 2) {
    SBAR(); qkt<DQK, KW, QSP>(pB0, pB1, K_lds + SHM_K, kb, qr, qsp, negm);
    finishSM(pA0, pA1, alA, l_reg, pa0, pa1, pa2, pa3); SBAR();
    SLOAD(SO, (j + SDEPTH)); SBAR();
    PVD0(o, vb0, pa0, pa1, pa2, pa3); PSM(pB0, pB1, mnB, alB, false);
    __syncthreads(); SWAIT(); SWRITE(0, SE);
    RESC(alB); __syncthreads();
    SBAR(); qkt<DQK, KW, QSP>(pA0, pA1, K_lds, kb, qr, qsp, negm);
    finishSM(pB0, pB1, alB, l_reg, pa0, pa1, pa2, pa3); SBAR();
    if (SDEPTH == 1 || j + 3 < NT) SLOAD(SE, (j + 1 + SDEPTH)); SBAR();
    PVD0(o, vb0 + SHM_V, pa0, pa1, pa2, pa3); PSM(pA0, pA1, mnA, alA, false);
    __syncthreads(); SWAIT(); SWRITE(1, SO);
    RESC(alA); __syncthreads();
  }
  } else {
  for (int j = 1; j + 1 < NT; j += 2) {
    SBAR(); finishSM(pA0, pA1, alA, l_reg, pa0, pa1, pa2, pa3); SBAR();
    qkt<DQK, KW, QSP>(pB0, pB1, K_lds + SHM_K, kb, qr, qsp, negm); SBAR();
    SLOAD(SO, (j + SDEPTH)); SBAR();
    PSM(pB0, pB1, mnB, alB, false); SBAR();
    PVD0(o, vb0, pa0, pa1, pa2, pa3);
    __syncthreads(); SWAIT(); SWRITE(0, SE);
    RESC(alB); __syncthreads();
    SBAR(); finishSM(pB0, pB1, alB, l_reg, pa0, pa1, pa2, pa3); SBAR();
    qkt<DQK, KW, QSP>(pA0, pA1, K_lds, kb, qr, qsp, negm); SBAR();
    if (SDEPTH == 1 || j + 3 < NT) SLOAD(SE, (j + 1 + SDEPTH)); SBAR();
    PSM(pA0, pA1, mnA, alA, false); SBAR();
    PVD0(o, vb0 + SHM_V, pa0, pa1, pa2, pa3);
    __syncthreads(); SWAIT(); SWRITE(1, SO);
    RESC(alA); __syncthreads();
  }
  }
  SBAR(); qkt<DQK, KW, QSP>(pB0, pB1, K_lds + SHM_K, kb, qr, qsp, negm);
  finishSM(pA0, pA1, alA, l_reg, pa0, pa1, pa2, pa3); SBAR();
  PVD0(o, vb0, pa0, pa1, pa2, pa3); PSM(pB0, pB1, mnB, alB, false);
  __syncthreads(); RESC(alB);
  finishSM(pB0, pB1, alB, l_reg, pa0, pa1, pa2, pa3); SBAR();
  PVD0(o, vb0 + SHM_V, pa0, pa1, pa2, pa3);
  }
  if (hi == 0) li_l[r32] = l_reg; asm volatile("s_waitcnt lgkmcnt(0)" ::: "memory");
  float rli[16];
#pragma unroll
  for (int r = 0; r < 16; ++r) rli[r] = __builtin_amdgcn_rcpf(li_l[crow(r, hi)]);
#pragma unroll
  for (int d0 = 0; d0 < 4; ++d0)
#pragma unroll
    for (int r = 0; r < 16; ++r) o[d0][r] *= rli[r];
  constexpr bool OUT_ALIAS = (QSP > 0) || (NBUF == 3);
  bf16_t* stg = (bf16_t*)(lds + (OUT_ALIAS ? 0 : NBUF * (SHM_V + SHM_K) + 2048)) + wid * 4096;
  u32x4 gv[8];
#define GATE_LOAD(NIT, RB) do { _Pragma("unroll") for (int i_ = 0; i_ < (NIT); ++i_) { const int idx_ = i_ * 64 + lane, row_ = (RB) + (idx_ >> 4), ch_ = idx_ & 15; \
      gv[i_] = *(const u32x4*)(P.Gw + (long)row_ * 2048 + ch_ * 8); } } while (0)
#define GATE_STORE(NIT, RB, STG) do { asm volatile("s_waitcnt lgkmcnt(0)" ::: "memory"); \
    _Pragma("unroll") for (int i_ = 0; i_ < (NIT); ++i_) { const int idx_ = i_ * 64 + lane, row_ = (RB) + (idx_ >> 4), ch_ = idx_ & 15; \
      const u32x4 ov_ = *(const u32x4*)((STG) + row_ * 128 + ch_ * 8); u32x4 w_; \
      _Pragma("unroll") for (int q_ = 0; q_ < 4; ++q_) w_[q_] = pk2(bflo(ov_[q_]) * silu_f(bflo(gv[i_][q_])), bfhi(ov_[q_]) * silu_f(bfhi(gv[i_][q_]))); \
      *(u32x4*)(P.Ow + (long)row_ * 2048 + ch_ * 8) = w_; } } while (0)
#define WG_BAR_LDS() asm volatile("s_waitcnt lgkmcnt(0)\n\ts_barrier" ::: "memory")
  if constexpr (!DIFF) {
    GATE_LOAD(8, 0);
    if constexpr (OUT_ALIAS) __syncthreads();
#pragma unroll
    for (int r = 0; r < 16; ++r) { const int ro = crow(r, hi) * 128 + r32;
#pragma unroll
      for (int d0 = 0; d0 < 4; ++d0) stg[ro + d0 * 32] = (bf16_t)f2bf(o[d0][r]); }
    GATE_STORE(8, 0, stg);
    WG_BAR_LDS();
  } else {
    __syncthreads();
    float* st = (float*)lds + (wid & 3) * 4096 + lane;
    if (wid >= 4) {
#pragma unroll
      for (int d0 = 0; d0 < 4; ++d0)
#pragma unroll
        for (int r = 0; r < 16; ++r) st[(d0 * 16 + r) * 64] = o[d0][r];
    }
    __syncthreads();
    bf16_t* stgp = (bf16_t*)(lds + (OUT_ALIAS ? 65536 : NBUF * (SHM_V + SHM_K) + 2048)) + (wid & 3) * 4096;
    GATE_LOAD(4, (wid >> 2) * 16);
    if (wid < 4) {
      float sg[4];
#pragma unroll
      for (int d0 = 0; d0 < 4; ++d0) sg[d0] = P.subg[d0 * 32 + r32] * P.osc;
#pragma unroll
      for (int r = 0; r < 16; ++r) { float ss = 0.f;
#pragma unroll
        for (int d0 = 0; d0 < 4; ++d0) { const float v = o[d0][r] - P.lam * st[(d0 * 16 + r) * 64]; o[d0][r] = v; ss += v * v; }
        ss += __shfl_xor(ss, 1); ss += __shfl_xor(ss, 2); ss += __shfl_xor(ss, 4); ss += __shfl_xor(ss, 8); ss += __shfl_xor(ss, 16);
        const float rstd = __builtin_amdgcn_rsqf(ss * (1.f / 128.f) + NORM_EPS); const int ro = crow(r, hi) * 128 + r32;
#pragma unroll
        for (int d0 = 0; d0 < 4; ++d0) stgp[ro + d0 * 32] = (bf16_t)f2bf(o[d0][r] * rstd * sg[d0]); }
    }
    WG_BAR_LDS();
    GATE_STORE(4, (wid >> 2) * 16, stgp);
    WG_BAR_LDS();
  }
#undef GATE_LOAD
#undef WG_BAR_LDS
#undef GATE_STORE
#undef PVD0
#undef PSM
#undef SLOAD
#undef SWRITE
#undef SWAIT
#undef RESC
}
#undef SBAR
}

struct KArgs { const float* in[44]; float* out; unsigned char* ws; int ph_lo, ph_hi; };

#define PICK4(l, a, b, c, d) ((l) == 0 ? (a) : (l) == 1 ? (b) : (l) == 2 ? (c) : (d))

__device__ __forceinline__ void p0_transpose_item(const float* W, int K, int N, bf16_t* WT, LAS float* scr, int item, int lane, int pmode = 0) {
    const int nblk = N / 32, kb = item / nblk, nb = item % nblk, k0 = 64 * kb, n0 = 32 * nb;
    const bool pg = (pmode == 1 && n0 < 4096) || (pmode == 2 && (n0 % 192) >= 128);
#pragma unroll 8
    for (int i = 0; i < 32; ++i) { const int kk = 2 * i + (lane >> 5); scr[kk * 33 + (lane & 31)] = W[(size_t)(k0 + kk) * N + n0 + (lane & 31)]; }
    LDS_WAIT(); asm volatile("" ::: "memory");
    const int c = lane & 7;
#pragma unroll
    for (int j = 0; j < 4; ++j) { const int n = (lane >> 3) + 8 * j; const LAS float* s = scr + (8 * c) * 33 + n;
        v4u o; o.x = pk2(s[0 * 33], s[1 * 33]); o.y = pk2(s[2 * 33], s[3 * 33]); o.z = pk2(s[4 * 33], s[5 * 33]); o.w = pk2(s[6 * 33], s[7 * 33]);
        const int nr = pg ? (8 * ((n >> 2) & 3) + 4 * (n >> 4) + (n & 3)) : n;
        *(GAS v4u*)(WT + (size_t)(n0 + nr) * K + k0 + 8 * c) = o; }
    LDS_WAIT(); asm volatile("" ::: "memory");
}

__device__ __forceinline__ void phase_prologue(const KArgs& A, LAS unsigned char* lds, int wave, int lane) {
    LAS float* sl = (LAS float*)lds;
    for (int i = otid(); i < 9 * 2048; i += 512) { const int v = i >> 11, k = i & 2047; const float x = v < 8 ? A.in[1][v * 2048 + k] : A.in[3][k]; sl[i] = silu_f(x); }
    __syncthreads();
    const int gw = blockIdx.x * NWAVES + wave, NGW = gridDim.x * NWAVES;
    float* part = (float*)(A.ws + OFF_G);
    for (int task = gw; task < 4 * 24 * ADA_SPLIT; task += NGW) {
        const int l = task / (24 * ADA_SPLIT), rem = task % (24 * ADA_SPLIT), cgp = rem / ADA_SPLIT, s = rem % ADA_SPLIT;
        constexpr int KS = 2048 / ADA_SPLIT;
        const float* W = PICK4(l, A.in[4], A.in[15], A.in[23], A.in[33]) + (size_t)(s * KS) * 6144 + cgp * 256 + lane * 4;
        f32x4 acc[9];
#pragma unroll
        for (int v = 0; v < 9; ++v) acc[v] = (f32x4){0.f, 0.f, 0.f, 0.f};
        for (int k0 = 0; k0 < KS; k0 += 8) {
            f32x4 w[8];
#pragma unroll
            for (int i = 0; i < 8; ++i) w[i] = *(const f32x4*)(W + (size_t)(k0 + i) * 6144);
#pragma unroll
            for (int i = 0; i < 8; ++i)
#pragma unroll
                for (int v = 0; v < 9; ++v) acc[v] += w[i] * sl[v * 2048 + s * KS + k0 + i];
        }
#pragma unroll
        for (int v = 0; v < 9; ++v) *(f32x4*)(part + ((size_t)(s * 4 + l) * 9 + v) * 6144 + cgp * 256 + lane * 4) = acc[v];
    }
    LAS float* scr = (LAS float*)(lds + 73728 + wave * 8448);
    constexpr int I0 = 32 * 256, I1 = 32 * 160, I2 = 32 * 98, IO = 32 * 64, IQ = 8 * 96, IKV = 8 * 128;
    constexpr int NITEMS = 2 * I0 + I1 + I2 + 4 * IO + IQ + IKV;
    for (int it = gw; it < NITEMS; it += NGW) {
        int r = it;
        if (r < I0) { p0_transpose_item(A.in[8], 2048, 8192, (bf16_t*)(A.ws + OFF_WIN0), scr, r, lane, 1); continue; } r -= I0;
        if (r < I0) { p0_transpose_item(A.in[37], 2048, 8192, (bf16_t*)(A.ws + OFF_WIN3), scr, r, lane, 1); continue; } r -= I0;
        if (r < I1) { p0_transpose_item(A.in[19], 2048, 5120, (bf16_t*)(A.ws + OFF_WIN1), scr, r, lane); continue; } r -= I1;
        if (r < I2) { p0_transpose_item(A.in[27], 2048, 3136, (bf16_t*)(A.ws + OFF_WIN2), scr, r, lane); continue; } r -= I2;
        if (r < 4 * IO) { const int l = r / IO; p0_transpose_item(PICK4(l, A.in[14], A.in[22], A.in[32], A.in[43]), 2048, 2048, (bf16_t*)(A.ws + OFF_WOUT) + (size_t)l * 2048 * 2048, scr, r % IO, lane); continue; } r -= 4 * IO;
        if (r < IQ) { p0_transpose_item(A.in[29], 512, 3072, (bf16_t*)(A.ws + OFF_WQB), scr, r, lane, 2); continue; } r -= IQ;
        p0_transpose_item(A.in[31], 512, 4096, (bf16_t*)(A.ws + OFF_WKVB), scr, r, lane);
    }
    { v4u* z = (v4u*)((bf16_t*)(A.ws + OFF_WIN2) + (size_t)3136 * 2048); const int n16 = 192 * 2048 * 2 / 16;
      unsigned zz = 0u; asm volatile("" : "+v"(zz));
      for (int i = blockIdx.x * 512 + otid(); i < n16; i += gridDim.x * 512) z[i] = (v4u){zz, zz, zz, zz}; }
}

__device__ __forceinline__ void phase_ada_reduce(const KArgs& A) {
    const float* part = (const float*)(A.ws + OFF_G); float* ada = (float*)(A.ws + OFF_ADA);
    constexpr int NTOT = 4 * 9 * 6144;
    for (int i = blockIdx.x * 512 + otid(); i < NTOT; i += gridDim.x * 512) {
        const int l = i / (9 * 6144), c = i % 6144;
        float s = PICK4(l, A.in[5], A.in[16], A.in[24], A.in[34])[c];
#pragma unroll
        for (int k = 0; k < ADA_SPLIT; ++k) s += part[(size_t)k * NTOT + i];
        ada[i] = s;
    }
}

__device__ __forceinline__ void phase_rowpass(const KArgs& A, int l, int wave, int lane, bool dummy = false) {
    const bool first = (l == 0), last = (l == 4);
    const int gw = blockIdx.x * NWAVES + wave, NGW = gridDim.x * NWAVES;
    const float* ada = (const float*)(A.ws + OFF_ADA);
    const int lp = l - 1;
    const float* post_g = first ? nullptr : PICK4(lp, A.in[7], A.in[18], A.in[26], A.in[36]);
    const float* pre_g = last ? nullptr : PICK4(l, A.in[6], A.in[17], A.in[25], A.in[35]);
    const bf16_t* Y = (const bf16_t*)(A.ws + OFF_Q); bf16_t* XN = (bf16_t*)(A.ws + (dummy ? OFF_G : OFF_XN)); float* hctx = (float*)(A.ws + OFF_HCTX);
    for (int r = gw; r < MROWS; r += NGW) {
        const int b = r / TB, t = r % TB; const bool lat = t < SEQ; const int v = lat ? b : 8;
        if (last && !lat) continue;
        const size_t hoff = lat ? ((size_t)b * SEQ + t) * DM : ((size_t)b * CTXL + (t - SEQ)) * DM;
        const float* hin = (l <= 1 ? (lat ? A.in[0] : A.in[2]) : (lat ? (const float*)A.out : (const float*)hctx)) + hoff;
        float* hout = dummy ? (float*)(A.ws + OFF_K) + (size_t)r * DM : (lat ? A.out : hctx) + hoff;
        f32x4 h[8];
#pragma unroll
        for (int j = 0; j < 8; ++j) h[j] = *(const f32x4*)(hin + 4 * lane + 256 * j);
        if (!first) {
            f32x4 y[8]; float ss = 0.f;
#pragma unroll
            for (int j = 0; j < 8; ++j) {
                if (lat || !GOUT_SPLIT) { const v2u w = *(const v2u*)(Y + (size_t)r * DM + 4 * lane + 256 * j); y[j] = (f32x4){bflo(w.x), bfhi(w.x), bflo(w.y), bfhi(w.y)}; }
                else { y[j] = (f32x4){0.f, 0.f, 0.f, 0.f};
#pragma unroll
                    for (int kq = 0; kq < 4; ++kq) { const v2u w = *(const v2u*)((const bf16_t*)(A.ws + OFF_V) + ((size_t)kq * 2048 + (size_t)b * CTXL + (t - SEQ)) * DM + 4 * lane + 256 * j);
                        y[j] += (f32x4){bflo(w.x), bfhi(w.x), bflo(w.y), bfhi(w.y)}; } }
                ss += (y[j].x * y[j].x + y[j].y * y[j].y) + (y[j].z * y[j].z + y[j].w * y[j].w); }
            const float rstd = 1.f / sqrtf(wave_sum(ss) * (1.f / DM) + NORM_EPS);
            const float* gate = ada + ((size_t)lp * 9 + v) * 6144 + 4096;
#pragma unroll
            for (int j = 0; j < 8; ++j) { const int c = 4 * lane + 256 * j; const f32x4 gt = *(const f32x4*)(gate + c), pg = *(const f32x4*)(post_g + c);
                h[j] += gt * (y[j] * rstd * pg); *(f32x4*)(hout + c) = h[j]; }
        }
        if (!last) {
            float ss = 0.f;
#pragma unroll
            for (int j = 0; j < 8; ++j) ss += (h[j].x * h[j].x + h[j].y * h[j].y) + (h[j].z * h[j].z + h[j].w * h[j].w);
            const float rstd = 1.f / sqrtf(wave_sum(ss) * (1.f / DM) + NORM_EPS);
            const float* shift = ada + ((size_t)l * 9 + v) * 6144; const float* scale = shift + 2048;
#pragma unroll
            for (int j = 0; j < 8; ++j) { const int c = 4 * lane + 256 * j; const f32x4 sh = *(const f32x4*)(shift + c), sc = *(const f32x4*)(scale + c), pg = *(const f32x4*)(pre_g + c);
                const f32x4 x = (h[j] * rstd * pg) * (sc + 1.f) + sh; v2u w; w.x = pk2(x.x, x.y); w.y = pk2(x.z, x.w);
                *(v2u*)(XN + (size_t)r * DM + c) = w; }
        }
    }
}

__device__ __forceinline__ void nr128(bf16_t* p, const float* g, bool lat, int t, int qd) {
    const int half = qd >> 1, jh = qd & 1, d0 = 64 * half + 16 * jh;
    v4u a0 = *(const v4u*)(p + d0), a1 = *(const v4u*)(p + d0 + 8), b0 = *(const v4u*)(p + d0 + 32), b1 = *(const v4u*)(p + d0 + 40);
    float xa[16], xb[16];
#pragma unroll
    for (int i = 0; i < 4; ++i) { xa[2 * i] = bflo(a0[i]); xa[2 * i + 1] = bfhi(a0[i]); xa[8 + 2 * i] = bflo(a1[i]); xa[8 + 2 * i + 1] = bfhi(a1[i]);
        xb[2 * i] = bflo(b0[i]); xb[2 * i + 1] = bfhi(b0[i]); xb[8 + 2 * i] = bflo(b1[i]); xb[8 + 2 * i + 1] = bfhi(b1[i]); }
    float ss = 0.f;
#pragma unroll
    for (int i = 0; i < 16; ++i) ss += xa[i] * xa[i] + xb[i] * xb[i];
    ss += __shfl_xor(ss, 1); ss += __shfl_xor(ss, 2);
    const float rstd = 1.f / sqrtf(ss * (1.f / 128.f) + NORM_EPS);
    const float pos = half ? (float)(t & 63) : (float)(t >> 6);
#pragma unroll
    for (int i = 0; i < 16; ++i) { float x1 = xa[i] * rstd * g[d0 + i], x2 = xb[i] * rstd * g[d0 + 32 + i];
        if (lat) { const float ang = pos * __builtin_amdgcn_exp2f(-(float)(16 * jh + i) * (13.287712379549449f / 32.f)); const float sn = __sinf(ang), cs = __cosf(ang);
            const float o1 = x1 * cs - x2 * sn, o2 = x1 * sn + x2 * cs; x1 = o1; x2 = o2; }
        xa[i] = x1; xb[i] = x2; }
#pragma unroll
    for (int i = 0; i < 4; ++i) { a0[i] = pk2(xa[2 * i], xa[2 * i + 1]); a1[i] = pk2(xa[8 + 2 * i], xa[8 + 2 * i + 1]); b0[i] = pk2(xb[2 * i], xb[2 * i + 1]); b1[i] = pk2(xb[8 + 2 * i], xb[8 + 2 * i + 1]); }
    *(v4u*)(p + d0) = a0; *(v4u*)(p + d0 + 8) = a1; *(v4u*)(p + d0 + 32) = b0; *(v4u*)(p + d0 + 40) = b1;
}
__device__ __forceinline__ void phase_post_gqa(const KArgs& A, int wave, int lane) {
    const int gw = blockIdx.x * NWAVES + wave, NGW = gridDim.x * NWAVES;
    bf16_t* Q = (bf16_t*)(A.ws + OFF_Q); bf16_t* K = (bf16_t*)(A.ws + OFF_K);
    for (int r = gw; r < MROWS; r += NGW) { const int t = r % TB; const bool lat = t < SEQ;
        nr128(Q + (size_t)r * 2048 + (lane >> 2) * 128, A.in[20], lat, t, lane & 3);
        if (lane < 16) nr128(K + (size_t)r * 512 + (lane >> 2) * 128, A.in[21], lat, t, lane & 3); }
}
__device__ __forceinline__ void phase_post_mla(const KArgs& A, int wave, int lane) {
    const int gw = blockIdx.x * NWAVES + wave, NGW = gridDim.x * NWAVES;
    const bf16_t* RAW = (const bf16_t*)(A.ws + OFF_V); bf16_t* NQA = (bf16_t*)(A.ws + OFF_XN); bf16_t* NKVA = NQA + (size_t)MROWS * 512; bf16_t* KR = (bf16_t*)(A.ws + OFF_KR);
    for (int r = gw; r < MROWS; r += NGW) { const int t = r % TB; const bool lat = t < SEQ; const bf16_t* row = RAW + (size_t)r * 1088;
#pragma unroll
        for (int part = 0; part < 2; ++part) {
            const v4u w = *(const v4u*)(row + part * 512 + 8 * lane); float x[8]; float ss = 0.f;
#pragma unroll
            for (int i = 0; i < 4; ++i) { x[2 * i] = bflo(w[i]); x[2 * i + 1] = bfhi(w[i]); ss += x[2 * i] * x[2 * i] + x[2 * i + 1] * x[2 * i + 1]; }
            const float rstd = 1.f / sqrtf(wave_sum(ss) * (1.f / 512.f) + NORM_EPS);
            const float* g = (part ? A.in[30] : A.in[28]) + 8 * lane; v4u o;
#pragma unroll
            for (int i = 0; i < 4; ++i) o[i] = pk2(x[2 * i] * rstd * g[2 * i], x[2 * i + 1] * rstd * g[2 * i + 1]);
            *(v4u*)((part ? NKVA : NQA) + (size_t)r * 512 + 8 * lane) = o;
        }
        if (lane < 32) { const int half = lane >> 4, j = lane & 15; float x1 = bf1(row[1024 + 32 * half + j]), x2 = bf1(row[1024 + 32 * half + 16 + j]);
            if (lat) { const float pos = half ? (float)(t & 63) : (float)(t >> 6); const float ang = pos * __builtin_amdgcn_exp2f(-(float)j * (13.287712379549449f / 16.f));
                const float sn = __sinf(ang), cs = __cosf(ang); const float o1 = x1 * cs - x2 * sn, o2 = x1 * sn + x2 * cs; x1 = o1; x2 = o2; }
            const int g1 = 8 * ((j >> 2) & 3) + (j & 3);
            KR[(size_t)r * 64 + 32 * half + g1] = (bf16_t)f2bf(x1); KR[(size_t)r * 64 + 32 * half + g1 + 4] = (bf16_t)f2bf(x2); }
    }
}

template <int DQK, int KW, bool DIFF, int SD, int QSP, int NBUF>
__device__ __forceinline__ void phase_attn(const KArgs& A, char* lds, int layer, bool need_ctx, int wave, int lane) {
    const bf16_t* Q = (const bf16_t*)(A.ws + OFF_Q); const bf16_t* K = (const bf16_t*)(A.ws + OFF_K); const bf16_t* V = (const bf16_t*)(A.ws + OFF_V);
    const bf16_t* G = (const bf16_t*)(A.ws + OFF_G); const bf16_t* KR = (const bf16_t*)(A.ws + OFF_KR); bf16_t* O = (bf16_t*)(A.ws + OFF_XN);
    float lam = 0.f, osc = 0.f; const float* subg = nullptr;
    if constexpr (DIFF) {
        const float* q1 = layer == 0 ? A.in[9] : A.in[38]; const float* k1 = layer == 0 ? A.in[10] : A.in[39];
        const float* q2 = layer == 0 ? A.in[11] : A.in[40]; const float* k2 = layer == 0 ? A.in[12] : A.in[41];
        const float linit = layer == 0 ? 0.2f : 0.55605820435704293f;
        lam = __expf(wave_sum(q1[lane] * k1[lane])) - __expf(wave_sum(q2[lane] * k2[lane])) + linit; osc = 1.f - linit;
        subg = layer == 0 ? A.in[13] : A.in[42];
    }
    constexpr int RPU = DIFF ? 128 : 256, UPB = SEQ / RPU, CPB = CTXL / RPU;
    const int nbig = NB * 16 * UPB, ntot = nbig + (need_ctx ? NB * 16 * CPB : 0);
    const int vcu = (gridDim.x % 8 == 0) ? (int)(blockIdx.x % 8) * (int)(gridDim.x / 8) + (int)(blockIdx.x / 8) : (int)blockIdx.x;
    for (int u = vcu; u < ntot; u += gridDim.x) {
        int bh, qrow, krow, nt;
        if (u < nbig) { bh = u / UPB; qrow = (u % UPB) * RPU; krow = 0; nt = TB / 64; }
        else { const int u2 = u - nbig; bh = u2 / CPB; qrow = SEQ + (u2 % CPB) * RPU; krow = SEQ; nt = CTXL / 64; }
        const int b = bh >> 4, h = bh & 15;
        const long r0 = (long)b * TB + qrow + (DIFF ? 32 * (wave & 3) : 32 * wave), k0 = (long)b * TB + krow;
        att::UnitP P;
        if constexpr (DIFF) { P.Qw = Q + r0 * 2048 + h * 128 + (wave >> 2) * 64; P.ldq = 2048; P.K0 = K + k0 * 2048 + h * 128; P.ldk0 = 2048; P.K1 = nullptr; P.ldk1 = 0; P.Vh = V + k0 * 2048 + h * 128; P.ldv = 2048; }
        else if constexpr (DQK == 128) { P.Qw = Q + r0 * 2048 + h * 128; P.ldq = 2048; P.K0 = K + k0 * 512 + (h >> 2) * 128; P.ldk0 = 512; P.K1 = nullptr; P.ldk1 = 0; P.Vh = V + k0 * 512 + (h >> 2) * 128; P.ldv = 512; }
        else { P.Qw = Q + r0 * 3072 + h * 192; P.ldq = 3072; P.K0 = K + k0 * 2048 + h * 128; P.ldk0 = 2048; P.K1 = KR + k0 * 64; P.ldk1 = 64; P.Vh = V + k0 * 2048 + h * 128; P.ldv = 2048; }
        P.Gw = G + r0 * 2048 + h * 128; P.Ow = O + r0 * 2048 + h * 128; P.nt = nt; P.lam = lam; P.osc = osc; P.subg = subg;
        att::attn_unit<DQK, KW, DIFF, SD, QSP, NBUF>(P, lds);
    }
}

#define XB_TMO      128
#define XB_XCNT(j)  (256  + 64 * (j))
#define XB_XSUB(j)  (1280 + 64 * (j))
#define XB_XGEN(j)  (2304 + 64 * (j))
#define XB_TOP      3328
#define XB_TOPGEN   3392
#define XCD_BAR_WORDS 3456
#define XB_SPIN_CAP (1u << 18)

__device__ __forceinline__ unsigned xb_ld(unsigned* p)              { return __hip_atomic_load(p, __ATOMIC_RELAXED, __HIP_MEMORY_SCOPE_AGENT); }
__device__ __forceinline__ unsigned xb_add(unsigned* p, unsigned v) { return __hip_atomic_fetch_add(p, v, __ATOMIC_RELAXED, __HIP_MEMORY_SCOPE_AGENT); }
__device__ __forceinline__ unsigned xb_xcc_id() { return (unsigned)__builtin_amdgcn_s_getreg((3 << 11) | 20) & 0xFu; }
#define XB_SPIN(cond, bar) do { unsigned _sp = 0; while (cond) { __builtin_amdgcn_s_sleep(1); \
    if ((++_sp & 255u) == 0u) { if (xb_ld(&(bar)[XB_TMO])) break; if (_sp > XB_SPIN_CAP) { atomicAdd(&(bar)[XB_TMO], 1u); break; } } } } while (0)

struct XcdBarrier {
    unsigned* bar; unsigned x;
    volatile LAS unsigned* st;
};

__device__ __forceinline__ XcdBarrier xcd_barrier_post(unsigned* bar, volatile LAS unsigned* st) {
    XcdBarrier b; b.bar = bar; b.x = xb_xcc_id(); b.st = st;
    if (threadIdx.x == 0) (void)xb_add(&bar[XB_XCNT(b.x)], 1u);
    return b;
}
__device__ __forceinline__ void xcd_barrier_complete(unsigned* bar, unsigned x, unsigned& nloc, unsigned& nx) {
    const unsigned G = gridDim.x * gridDim.y * gridDim.z;
    unsigned sum, cnt, mine, sp = 0u;
    for (;;) {
        sum = 0u; cnt = 0u; mine = 0u;
#pragma unroll
        for (unsigned j = 0; j < 16; ++j) { const unsigned c = xb_ld(&bar[XB_XCNT(j)]); sum += c; cnt += (c > 0u) ? 1u : 0u; mine = (j == x) ? c : mine; }
        if (sum == G) break;
        __builtin_amdgcn_s_sleep(1);
        if ((++sp & 255u) == 0u) { if (xb_ld(&bar[XB_TMO])) break; if (sp > XB_SPIN_CAP) { atomicAdd(&bar[XB_TMO], 1u); break; } }
    }
    nloc = mine > 0u ? mine : 1u; nx = cnt > 0u ? cnt : 1u;
}

__device__ __forceinline__ void xcd_barrier(const XcdBarrier& b) {
    asm volatile("s_waitcnt vmcnt(0)" ::: "memory");
    __syncthreads();
    if (threadIdx.x == 0) {
        unsigned* bar = b.bar;
        __builtin_amdgcn_s_waitcnt(0);
        unsigned nloc = b.st[0], nx = b.st[1];
        if (nloc == 0u) { xcd_barrier_complete(bar, b.x, nloc, nx); b.st[0] = nloc; b.st[1] = nx; }
        const unsigned old = xb_add(&bar[XB_XSUB(b.x)], 1u);
        const unsigned gen = old / nloc;
        if (old + 1u == (gen + 1u) * nloc) {
            __builtin_amdgcn_fence(__ATOMIC_RELEASE, "agent");
            asm volatile("s_waitcnt vmcnt(0)" ::: "memory");
            const unsigned og = xb_add(&bar[XB_TOP], 1u);
            const unsigned tg = og / nx;
            if (og + 1u == (tg + 1u) * nx) xb_add(&bar[XB_TOPGEN], 1u);
            else XB_SPIN(xb_ld(&bar[XB_TOPGEN]) == tg, bar);
            __builtin_amdgcn_fence(__ATOMIC_ACQUIRE, "agent");
            xb_add(&bar[XB_XGEN(b.x)], 1u);
            asm volatile("s_waitcnt vmcnt(0)" ::: "memory");
        } else {
            XB_SPIN(xb_ld(&bar[XB_XGEN(b.x)]) == gen, bar);
            __builtin_amdgcn_fence(__ATOMIC_ACQUIRE, "agent");
            asm volatile("s_waitcnt vmcnt(0)" ::: "memory");
        }
    }
    __syncthreads();
}

__global__ void __launch_bounds__(512) fwd_kernel(KArgs A0) {
    extern __shared__ __attribute__((aligned(16))) unsigned char lds[];
    cg::grid_group grid = cg::this_grid();
    LAS unsigned char* ldsl = (LAS unsigned char*)lds;
    volatile LAS unsigned* bst = (volatile LAS unsigned*)(ldsl + LDS_BYTES - 16);
    if (threadIdx.x < 4) bst[threadIdx.x] = 0u;
    __syncthreads();
    XcdBarrier xbar = xcd_barrier_post((unsigned*)(A0.ws + OFF_BAR), bst);
#ifndef REPMASK
#define REPMASK 0
#endif
    const int ph_lo = A0.ph_lo, ph_hi = A0.ph_hi;
    if (ph_lo < 0) grid.sync();
    for (int ph = ph_lo; ph < ph_hi; ++ph) {
      {
        const int tid_ = otid(); const int lane = tid_ & 63, wave = __builtin_amdgcn_readfirstlane(tid_ >> 6);
        const KArgs __attribute__((address_space(4)))* ap_ = (const KArgs __attribute__((address_space(4)))*)__builtin_amdgcn_kernarg_segment_ptr();
        asm volatile("" : "+s"(ap_));
        const KArgs& A = *(const KArgs*)ap_;
        unsigned char* ws = A.ws;
#ifndef PM
#define PM 0xff
#endif
#ifndef ATT_NBUF
#define ATT_NBUF 3
#endif
#define ATT_SD0 (ATT_NBUF == 3 ? 1 : ATT_SD)
#ifndef ATT_SD
#define ATT_SD 2
#endif
        if (ph == PH_PRO) { if (PM & 1) phase_prologue(A, ldsl, wave, lane); }
        else if (ph == PH_ADA) phase_ada_reduce(A);
        else if (ph == PH_L0_ROW || ph == PH_L1_ROW || ph == PH_L2_ROW || ph == PH_L3_ROW || ph == PH_FIN)
            { if (PM & 2) phase_rowpass(A, ph == PH_L0_ROW ? 0 : ph == PH_L1_ROW ? 1 : ph == PH_L2_ROW ? 2 : ph == PH_L3_ROW ? 3 : 4, wave, lane); }
        else if (ph == PH_L1_POST) { if (PM & 4) phase_post_gqa(A, wave, lane); }
        else if (ph == PH_L2_POST) { if (PM & 4) phase_post_mla(A, wave, lane); }
        else if (ph == PH_L0_ATT || ph == PH_L3_ATT) { if (PM & 8) phase_attn<64, 128, true, ATT_SD0, 0, ATT_NBUF>(A, (char*)lds, ph == PH_L0_ATT ? 0 : 3, ph == PH_L0_ATT, wave, lane); }
        else if (ph == PH_L1_ATT) { if (PM & 16) phase_attn<128, 128, false, ATT_SD0, 4, ATT_NBUF>(A, (char*)lds, 1, true, wave, lane); }
        else if (ph == PH_L2_ATT) { if (PM & 32) phase_attn<192, 192, false, 1, 3, ATT_NBUF>(A, (char*)lds, 2, true, wave, lane); }
        else if (PM & 64) {
            bf16_t* XN = (bf16_t*)(ws + OFF_XN);
            const bool is_gout = (ph == PH_L0_GOUT || ph == PH_L1_GOUT || ph == PH_L2_GOUT || ph == PH_L3_GOUT);
            pg8::Gemm g; EpiRoute E; E.ph = ph; E.ws = ws;
            g.A = XN; g.M = MROWS; g.K = 2048; g.ld = 2048;
            if (ph == PH_L0_GIN || ph == PH_L3_GIN) { g.Bt = (const bf16_t*)(ws + (ph == PH_L0_GIN ? OFF_WIN0 : OFF_WIN3)); g.N = 8192; }
            else if (ph == PH_L1_GIN) { g.Bt = (const bf16_t*)(ws + OFF_WIN1); g.N = 5120; }
            else if (ph == PH_L2_GIN) { g.Bt = (const bf16_t*)(ws + OFF_WIN2); g.N = 3328; }
            else if (ph == PH_L2_GQ) { g.K = 512; g.ld = 512; g.Bt = (const bf16_t*)(ws + OFF_WQB); g.N = 3072; }
            else if (ph == PH_L2_GKV) { g.A = XN + (size_t)MROWS * 512; g.K = 512; g.ld = 512; g.Bt = (const bf16_t*)(ws + OFF_WKVB); g.N = 4096; }
            else { const int l = ph == PH_L0_GOUT ? 0 : ph == PH_L1_GOUT ? 1 : ph == PH_L2_GOUT ? 2 : 3; g.Bt = (const bf16_t*)(ws + OFF_WOUT) + (size_t)l * 2048 * 2048; g.N = 2048; }
            pg8::StaticOrder S; S.init(g.M, g.N, (int)gridDim.x, (int)blockIdx.x);
            if (ph == PH_L3_GOUT) { S.init(NB * SEQ, g.N, (int)gridDim.x, (int)blockIdx.x); S.skip9 = true; }
            pg8::gemm_phase<EpiRoute, pg8::StaticOrder, true, true>(ldsl, g, S, E);
        }
      }
        if (ph + 1 < ph_hi && ph != PH_L2_GQ) { unsigned* bp_ = xbar.bar; asm volatile("" : "+s"(bp_)); XcdBarrier xb_ = xbar; xb_.bar = bp_; xcd_barrier(xb_); }
    }
}

#ifndef MK_ONE_LAUNCH
#define MK_ONE_LAUNCH 1
#endif
extern "C" void kernel_launch(void* const* d_in, const int* in_sizes, int n_in, void* d_out, int out_size, void* d_ws, size_t ws_size, hipStream_t stream) {
    static int grid = 0;
    if (grid == 0) {
        if (n_in != 44 || out_size != NB * SEQ * DM || ws_size < WS_END) { fprintf(stderr, "kernel_launch: unexpected shapes n_in %d out %d ws %zu (need %zu)\n", n_in, out_size, ws_size, (size_t)WS_END); grid = -1; return; }
        int dev = 0, cus = 0, per_cu = 0;
        hipGetDevice(&dev); hipDeviceGetAttribute(&cus, hipDeviceAttributeMultiprocessorCount, dev);
        if (hipFuncSetAttribute((const void*)fwd_kernel, hipFuncAttributeMaxDynamicSharedMemorySize, LDS_BYTES) != hipSuccess) { fprintf(stderr, "kernel_launch: hipFuncSetAttribute failed\n"); grid = -1; return; }
        if (hipOccupancyMaxActiveBlocksPerMultiprocessor(&per_cu, (const void*)fwd_kernel, 512, LDS_BYTES) != hipSuccess || per_cu < 1) { fprintf(stderr, "kernel_launch: occupancy query gave %d\n", per_cu); per_cu = 1; }
        (void)hipGetLastError();
        grid = cus * per_cu; if (grid > 256) grid = 256;
        fprintf(stderr, "kernel_launch: grid %d (cus %d x %d)\n", grid, cus, per_cu);
    }
    if (grid < 0) return;
    if (hipMemsetAsync((char*)d_ws + OFF_BAR, 0, 16384, stream) != hipSuccess) { fprintf(stderr, "kernel_launch: memset failed\n"); return; }
    KArgs a{};
    for (int i = 0; i < 44; ++i) a.in[i] = (const float*)d_in[i];
    a.out = (float*)d_out; a.ws = (unsigned char*)d_ws;
#if MK_ONE_LAUNCH
    a.ph_lo = 0; a.ph_hi = NPH;
    void* args[] = {&a};
    hipError_t e = hipLaunchCooperativeKernel((const void*)fwd_kernel, dim3(grid), dim3(512), args, LDS_BYTES, stream);
    if (e != hipSuccess) fprintf(stderr, "kernel_launch: cooperative launch failed: %s (grid %d)\n", hipGetErrorString(e), grid);
#else
    for (int ph = 0; ph < NPH; ++ph) { a.ph_lo = ph; a.ph_hi = ph + 1; hipLaunchKernelGGL(fwd_kernel, dim3(grid), dim3(512), LDS_BYTES, stream, a); }
#endif
}
```
